# Optimizing an MI355X kernel written in HIP

```python
import jax, jax.numpy as jnp
from jax import lax
import numpy as np

D_MODEL = 2048
BATCH = 1
SEQ = 16384
DEPTH = 1

HEAD_DIM = 128
ROT_DIM = HEAD_DIM // 4
ROPE_THETA = 500000.0
DIL_PATTERNS = ((128, 1), (512, 4), (2048, 16))
N_DIL_GROUPS = len(DIL_PATTERNS)
HEADS_PER_GROUP = 4
ATTN_WIDTH = N_DIL_GROUPS * HEADS_PER_GROUP * HEAD_DIM
ATTN_OUT = HEADS_PER_GROUP * HEAD_DIM
ATTN_BLOCK = 128
NEG_INF = -1e30
CHUNK = 128
SGU_GROUPS = 8
SGU_GROUP_DIM = 128
SGU_WIDTH = SGU_GROUPS * SGU_GROUP_DIM
IN_WIDTH = 3 * ATTN_WIDTH + 2 * SGU_WIDTH + 2 * D_MODEL
IN_SPLITS = (ATTN_WIDTH, 2 * ATTN_WIDTH, 3 * ATTN_WIDTH, 3 * ATTN_WIDTH + 2 * SGU_WIDTH,
             3 * ATTN_WIDTH + 2 * SGU_WIDTH + D_MODEL)
N_EXPERTS = 32
TOP_K = 4
D_EXPERT = D_MODEL
SWIGLU_LIMIT = 7.0
SWIGLU_ALPHA = 1.702
MOE_BLOCK = 128
LN_EPS = 1e-5
DEEPNORM_ALPHA = (2 * DEPTH) ** 0.25
DEEPNORM_BETA = (8 * DEPTH) ** -0.25

kernel_name = 'hybrid_dilated_sgu_moe_deepnorm_encoder'


def layer_norm(x, g, b):
    xf = x.astype(jnp.float32)
    mu = jnp.mean(xf, -1, keepdims=True)
    var = jnp.mean(jnp.square(xf - mu), -1, keepdims=True)
    return ((xf - mu) * lax.rsqrt(var + LN_EPS) * g + b).astype(x.dtype)


def rope_partial(t, cos, sin):
    half = ROT_DIM // 2
    r1, r2, rest = t[..., :half], t[..., half:ROT_DIM], t[..., ROT_DIM:]
    rot = jnp.concatenate([r1 * cos - r2 * sin, r2 * cos + r1 * sin], -1).astype(t.dtype)
    return jnp.concatenate([rot, rest], -1)


def banded_attention(q, k, v, half):
    N, L, H, hd = q.shape
    nb = -(-L // ATTN_BLOCK)
    Lp = nb * ATTN_BLOCK
    band = ATTN_BLOCK + 2 * half
    qb = jnp.pad(q, ((0, 0), (0, Lp - L), (0, 0), (0, 0))).reshape(N, nb, ATTN_BLOCK, H, hd)
    pad_kv = ((0, 0), (half, Lp - L + half), (0, 0), (0, 0))
    kp, vp = jnp.pad(k, pad_kv), jnp.pad(v, pad_kv)
    idx = (jnp.arange(nb) * ATTN_BLOCK)[:, None] + jnp.arange(band)[None, :]
    kb, vb = kp[:, idx], vp[:, idx]
    s = jnp.einsum('nbqhd,nbkhd->nbhqk', qb, kb).astype(jnp.float32) * (hd ** -0.5)
    qpos = (jnp.arange(nb) * ATTN_BLOCK)[:, None] + jnp.arange(ATTN_BLOCK)[None, :]
    kpos = idx - half
    rel = kpos[:, None, :] - qpos[:, :, None]
    mask = (jnp.abs(rel) <= half) & (kpos[:, None, :] >= 0) & (kpos[:, None, :] < L)
    s = jnp.where(mask[None, :, None], s, NEG_INF)
    m = jnp.max(s, -1, keepdims=True)
    p = jnp.exp(s - m)
    den = jnp.sum(p, -1, keepdims=True)
    lse = (m + jnp.log(den))[..., 0]
    o = jnp.einsum('nbhqk,nbkhd->nbqhd', (p / den).astype(v.dtype), vb)
    o = o.reshape(N, Lp, H, hd)[:, :L]
    lse = lse.transpose(0, 1, 3, 2).reshape(N, Lp, H)[:, :L]
    return o, lse


def dilated_window_attention(q, k, v, window, dilation):
    B, S, H, hd = q.shape
    L = S // dilation
    def split(t):
        return t.reshape(B, L, dilation, H, hd).transpose(0, 2, 1, 3, 4).reshape(B * dilation, L, H, hd)
    o, lse = banded_attention(split(q), split(k), split(v), window // (2 * dilation))
    o = o.reshape(B, dilation, L, H, hd).transpose(0, 2, 1, 3, 4).reshape(B, S, H, hd)
    lse = lse.reshape(B, dilation, L, H).transpose(0, 2, 1, 3).reshape(B, S, H)
    return o, lse


def token_mixers(x, positions, w_in, w_attn_out, sgu_ln_g, sgu_ln_b, sgu_w, sgu_b, w_sgu_out, w_out):
    B, S, _ = x.shape
    proj = x @ w_in
    q, k, v, z, g_attn, g_sgu = jnp.split(proj, IN_SPLITS, axis=-1)
    inv_freq = ROPE_THETA ** (-jnp.arange(0, ROT_DIM, 2, dtype=jnp.float32) / ROT_DIM)
    ang = positions.astype(jnp.float32)[..., None] * inv_freq
    cos = jnp.cos(ang)[:, :, None, None, :]
    sin = jnp.sin(ang)[:, :, None, None, :]
    shp = (B, S, N_DIL_GROUPS, HEADS_PER_GROUP, HEAD_DIM)
    q = rope_partial(q.reshape(shp), cos, sin)
    k = rope_partial(k.reshape(shp), cos, sin)
    v = v.reshape(shp)
    outs, lses = [], []
    for gi, (window, dilation) in enumerate(DIL_PATTERNS):
        o_g, lse_g = dilated_window_attention(q[:, :, gi], k[:, :, gi], v[:, :, gi], window, dilation)
        outs.append(o_g)
        lses.append(lse_g)
    wts = jax.nn.softmax(jnp.stack(lses, 0), axis=0)
    o_a = jnp.sum(wts[..., None].astype(v.dtype) * jnp.stack(outs, 0), axis=0)
    y_a = o_a.reshape(B, S, ATTN_OUT) @ w_attn_out
    z = jax.nn.gelu(z, approximate=False)
    u, vv = z[..., :SGU_WIDTH], z[..., SGU_WIDTH:]
    vv = layer_norm(vv, sgu_ln_g, sgu_ln_b)
    vc = vv.reshape(B, S // CHUNK, CHUNK, SGU_GROUPS, SGU_GROUP_DIM)
    mixed = jnp.einsum('gts,bnsgc->bntgc', sgu_w, vc) + sgu_b.T[:, :, None]
    y_b = (u * mixed.reshape(B, S, SGU_WIDTH)) @ w_sgu_out
    merged = jax.nn.sigmoid(g_attn) * y_a + jax.nn.sigmoid(g_sgu) * y_b
    return merged @ w_out


def moe(x2d, w_router, b_router, w_gate_up, b_gate_up, w_down, b_down):
    T, D = x2d.shape
    logits = (x2d @ w_router + b_router).astype(jnp.float32)
    top_val, top_idx = lax.top_k(logits, TOP_K)
    gate = jax.nn.softmax(top_val, axis=-1)
    n = T * TOP_K
    flat_e = top_idx.reshape(-1)
    flat_t = jnp.repeat(jnp.arange(T, dtype=jnp.int32), TOP_K)
    flat_w = gate.reshape(-1)
    order = jnp.argsort(flat_e)
    se, st, sw = flat_e[order], flat_t[order], flat_w[order]
    counts = jnp.bincount(flat_e, length=N_EXPERTS)
    padded = (counts + MOE_BLOCK - 1) // MOE_BLOCK * MOE_BLOCK
    starts = jnp.cumsum(counts) - counts
    pends = jnp.cumsum(padded)
    pstarts = pends - padded
    dest = pstarts[se] + (jnp.arange(n) - starts[se])
    n_blocks = -(-n // MOE_BLOCK) + N_EXPERTS
    rows = n_blocks * MOE_BLOCK
    row_tok = jnp.full((rows,), T, jnp.int32).at[dest].set(st)
    row_w = jnp.zeros((rows,), jnp.float32).at[dest].set(sw)
    block_e = jnp.clip(jnp.searchsorted(pends, jnp.arange(n_blocks) * MOE_BLOCK, side='right'),
                       0, N_EXPERTS - 1)
    x_pad = jnp.concatenate([x2d, jnp.zeros((1, D), x2d.dtype)], 0)
    xb = x_pad[row_tok].reshape(n_blocks, MOE_BLOCK, D)

    def expert_block(args):
        xblk, e = args
        gu = xblk @ w_gate_up[e] + b_gate_up[e]
        g, up = gu[:, :D_EXPERT], gu[:, D_EXPERT:]
        g = jnp.minimum(g, SWIGLU_LIMIT)
        up = jnp.clip(up, -SWIGLU_LIMIT, SWIGLU_LIMIT)
        h = (up + 1.0) * (g * jax.nn.sigmoid(SWIGLU_ALPHA * g))
        return h @ w_down[e] + b_down[e]

    yb = lax.map(expert_block, (xb, block_e)).reshape(rows, D)
    y = jax.ops.segment_sum(yb.astype(jnp.float32) * row_w[:, None], row_tok, num_segments=T + 1)[:T]
    return y.astype(x2d.dtype)


def setup_inputs(seed: int = 0) -> dict:
    key = jax.random.key(seed)
    ks = jax.random.split(key, 24)
    f32 = jnp.float32
    def nrm(k, shape, scale):
        return jax.random.normal(k, shape, f32) * scale
    L = DEPTH
    return {
        'x': nrm(ks[0], (BATCH, SEQ, D_MODEL), 1.0),
        'positions': jnp.broadcast_to(jnp.arange(SEQ, dtype=jnp.int32)[None, :], (BATCH, SEQ)),
        'w_in': nrm(ks[1], (L, D_MODEL, IN_WIDTH), D_MODEL ** -0.5),
        'w_attn_out': nrm(ks[2], (L, ATTN_OUT, D_MODEL), ATTN_OUT ** -0.5),
        'sgu_ln_g': 1.0 + nrm(ks[3], (L, SGU_WIDTH), 0.02),
        'sgu_ln_b': nrm(ks[4], (L, SGU_WIDTH), 0.02),
        'sgu_w': nrm(ks[5], (L, SGU_GROUPS, CHUNK, CHUNK), CHUNK ** -0.5),
        'sgu_b': 1.0 + nrm(ks[6], (L, SGU_GROUPS, CHUNK), 0.02),
        'w_sgu_out': nrm(ks[7], (L, SGU_WIDTH, D_MODEL), SGU_WIDTH ** -0.5),
        'w_out': nrm(ks[8], (L, D_MODEL, D_MODEL), DEEPNORM_BETA * D_MODEL ** -0.5),
        'ln1_g': 1.0 + nrm(ks[9], (L, D_MODEL), 0.02),
        'ln1_b': nrm(ks[10], (L, D_MODEL), 0.02),
        'w_router': nrm(ks[11], (L, D_MODEL, N_EXPERTS), D_MODEL ** -0.5),
        'b_router': nrm(ks[12], (L, N_EXPERTS), 0.01),
        'w_gate_up': nrm(ks[13], (L, N_EXPERTS, D_MODEL, 2 * D_EXPERT), D_MODEL ** -0.5),
        'b_gate_up': nrm(ks[14], (L, N_EXPERTS, 2 * D_EXPERT), 0.02),
        'w_down': nrm(ks[15], (L, N_EXPERTS, D_EXPERT, D_MODEL), DEEPNORM_BETA * D_EXPERT ** -0.5),
        'b_down': nrm(ks[16], (L, N_EXPERTS, D_MODEL), 0.02),
        'ln2_g': 1.0 + nrm(ks[17], (L, D_MODEL), 0.02),
        'ln2_b': nrm(ks[18], (L, D_MODEL), 0.02),
    }


def reference(x, positions, w_in, w_attn_out, sgu_ln_g, sgu_ln_b, sgu_w, sgu_b, w_sgu_out, w_out,
              ln1_g, ln1_b, w_router, b_router, w_gate_up, b_gate_up, w_down, b_down, ln2_g, ln2_b):
    B, S, D = x.shape
    for l in range(DEPTH):
        h = token_mixers(x, positions, w_in[l], w_attn_out[l], sgu_ln_g[l], sgu_ln_b[l], sgu_w[l],
                         sgu_b[l], w_sgu_out[l], w_out[l])
        x = layer_norm(DEEPNORM_ALPHA * x + h, ln1_g[l], ln1_b[l])
        y = moe(x.reshape(B * S, D), w_router[l], b_router[l], w_gate_up[l], b_gate_up[l],
                w_down[l], b_down[l]).reshape(B, S, D)
        x = layer_norm(DEEPNORM_ALPHA * x + y, ln2_g[l], ln2_b[l])
    return x
```

```cpp
#include <hip/hip_runtime.h>
#include <cstdio>
#include <cstdint>

#define LAS __attribute__((address_space(3)))
#define GAS __attribute__((address_space(1)))
typedef unsigned short bf16;
typedef short bf16x8 __attribute__((ext_vector_type(8)));
typedef short s16x4 __attribute__((ext_vector_type(4)));
typedef float f32x4 __attribute__((ext_vector_type(4)));
typedef float f32x2 __attribute__((ext_vector_type(2)));
typedef unsigned u32x4 __attribute__((ext_vector_type(4)));
typedef unsigned u32x2 __attribute__((ext_vector_type(2)));
typedef _Float16 h16x8 __attribute__((ext_vector_type(8)));

constexpr int S = 16384, D = 2048, INW = 10752, AW = 1536, AO = 512, SW = 1024, NE = 32, TOPK = 4, DE = 2048;
constexpr int MAXROWS = 73728;
constexpr float LN_EPS = 1e-5f;
constexpr float ALPHA = 1.18920711500272106672f;

constexpr size_t MiB = 1u << 20;
constexpr size_t WS_CTL = 0, CTL_ZERO_BYTES = 64 * 1024;
constexpr size_t WS_XB = 1 * MiB;
constexpr size_t WS_WIN = WS_XB + 64 * MiB;
constexpr size_t WS_WA = WS_WIN + 42 * MiB;
constexpr size_t WS_WB = WS_WA + 2 * MiB;
constexpr size_t WS_WO = WS_WB + 4 * MiB;
constexpr size_t WS_WGU = WS_WO + 8 * MiB;
constexpr size_t WS_WD = WS_WGU + 512 * MiB;
constexpr size_t WS_SGW = WS_WD + 256 * MiB;
constexpr size_t WS_WRT = WS_SGW + 512 * 1024;
constexpr size_t WS_VST = WS_SGW + 768 * 1024;
constexpr size_t WS_CS = WS_SGW + 1 * MiB;
constexpr size_t WS_QB = WS_CS + 2 * MiB;
constexpr size_t WS_KB = WS_QB + 48 * MiB;
constexpr size_t WS_VB = WS_KB + 48 * MiB;
constexpr size_t WS_ZB = WS_VB + 48 * MiB;
constexpr size_t WS_GT = WS_ZB + 64 * MiB;
constexpr size_t WS_OG = WS_GT + 128 * MiB;
constexpr size_t WS_LSE = WS_OG + 96 * MiB;
constexpr size_t WS_OA = WS_LSE + 1 * MiB;
constexpr size_t WS_SGI = WS_OA + 16 * MiB;
constexpr size_t WS_MRG = WS_SGI + 32 * MiB;
constexpr size_t WS_X1F = WS_MRG + 64 * MiB;
constexpr size_t WS_X1B = WS_X1F + 128 * MiB;
constexpr size_t WS_STOK = WS_X1B + 64 * MiB;
constexpr size_t WS_SGATE = WS_STOK + 2 * MiB;
constexpr size_t WS_INV = WS_SGATE + 2 * MiB;
constexpr size_t WS_RGATE = WS_INV + 1 * MiB;
constexpr size_t WS_XS = WS_RGATE + 1 * MiB;
constexpr size_t WS_HB = WS_XS + 288 * MiB;
constexpr size_t WS_YB = WS_HB + 288 * MiB;
constexpr size_t WS_X8 = WS_YB + 288 * MiB;
constexpr size_t WS_WIN8 = WS_X8 + 32 * MiB;
constexpr size_t WS_END = WS_WIN8 + 17 * MiB;
constexpr int CW_TMO = 0, CW_BAR = 4096, CW_Q1 = 8192;

constexpr int RING_BYTES = 131072;
constexpr int XLP = 2052;
constexpr int LDS_PART = 16 * XLP * 4 + 256;
constexpr int LDS_MISC = LDS_PART + 16384;
constexpr int MISC_BAR = 0;
constexpr int MISC_QS = 16;
constexpr int MISC_TP = 64;
constexpr int MISC_CNT = 256;
constexpr int MISC_BASE = 384;
constexpr int MISC_LC = 512;
constexpr int MISC_LG = 1024;
constexpr int MISC_PART = 4096;
constexpr int LDS_BYTES = LDS_MISC + 8192;
static_assert(LDS_PART >= RING_BYTES && LDS_BYTES <= 163840, "LDS map");

__device__ __forceinline__ unsigned cvt_pk_bf16(float lo, float hi) { unsigned r; asm volatile("v_cvt_pk_bf16_f32 %0, %1, %2" : "=v"(r) : "v"(lo), "v"(hi)); return r; }
__device__ __forceinline__ float bflo(unsigned w) { return __uint_as_float(w << 16); }
__device__ __forceinline__ float bfhi(unsigned w) { return __uint_as_float(w & 0xffff0000u); }
__device__ __forceinline__ float wave_sum(float v) {
#pragma unroll
    for (int o = 1; o < 64; o <<= 1) v += __shfl_xor(v, o);
    return v;
}
__device__ __forceinline__ float fast_exp2(float x) { return __builtin_amdgcn_exp2f(x); }
__device__ __forceinline__ float sigmoidf_(float x) { return __builtin_amdgcn_rcpf(1.0f + fast_exp2(-1.44269504089f * x)); }

__device__ __forceinline__ int hw_lane() { int l; asm volatile("v_mbcnt_lo_u32_b32 %0, -1, 0\n\tv_mbcnt_hi_u32_b32 %0, -1, %0" : "=v"(l)); return l; }

#define XB_TMO      128
#define XB_XCNT(j)  (256  + 64 * (j))
#define XB_XSUB(j)  (1280 + 64 * (j))
#define XB_XGEN(j)  (2304 + 64 * (j))
#define XB_TOP      3328
#define XB_TOPGEN   3392
#define XCD_BAR_WORDS 3456
#define XB_SPIN_CAP (1u << 18)
__device__ __forceinline__ unsigned xb_ld(unsigned* p)              { return __hip_atomic_load(p, __ATOMIC_RELAXED, __HIP_MEMORY_SCOPE_AGENT); }
__device__ __forceinline__ unsigned xb_add(unsigned* p, unsigned v) { return __hip_atomic_fetch_add(p, v, __ATOMIC_RELAXED, __HIP_MEMORY_SCOPE_AGENT); }
__device__ __forceinline__ unsigned xb_xcc_id() { return (unsigned)__builtin_amdgcn_s_getreg((3 << 11) | 20) & 0xFu; }
#define XB_SPIN(cond, bar) do { unsigned _sp = 0; while (cond) { __builtin_amdgcn_s_sleep(1); \
    if ((++_sp & 255u) == 0u) { if (xb_ld(&(bar)[XB_TMO])) break; if (_sp > XB_SPIN_CAP) { atomicAdd(&(bar)[XB_TMO], 1u); break; } } } } while (0)
struct XcdBarrier { unsigned* bar; unsigned x; volatile LAS unsigned* st; };
__device__ __forceinline__ XcdBarrier xcd_barrier_post(unsigned* bar, volatile LAS unsigned* st, bool t0) {
    XcdBarrier b; b.bar = bar; b.x = xb_xcc_id(); b.st = st;
    if (t0) (void)xb_add(&bar[XB_XCNT(b.x)], 1u);
    return b;
}
__device__ __forceinline__ void xcd_barrier_complete(unsigned* bar, unsigned x, unsigned& nloc, unsigned& nx) {
    const unsigned G = gridDim.x * gridDim.y * gridDim.z;
    unsigned sum, cnt, mine, sp = 0u;
    for (;;) {
        sum = 0u; cnt = 0u; mine = 0u;
#pragma unroll
        for (unsigned j = 0; j < 16; ++j) { const unsigned c = xb_ld(&bar[XB_XCNT(j)]); sum += c; cnt += (c > 0u) ? 1u : 0u; mine = (j == x) ? c : mine; }
        if (sum == G) break;
        __builtin_amdgcn_s_sleep(1);
        if ((++sp & 255u) == 0u) { if (xb_ld(&bar[XB_TMO])) break; if (sp > XB_SPIN_CAP) { atomicAdd(&bar[XB_TMO], 1u); break; } }
    }
    nloc = mine > 0u ? mine : 1u; nx = cnt > 0u ? cnt : 1u;
}
__device__ __forceinline__ void xcd_barrier(const XcdBarrier& b, bool t0) {
    asm volatile("s_waitcnt vmcnt(0)" ::: "memory");
    __syncthreads();
    if (t0) {
        unsigned* bar = b.bar;
        __builtin_amdgcn_s_waitcnt(0);
        unsigned nloc = b.st[0], nx = b.st[1];
        if (nloc == 0u) { xcd_barrier_complete(bar, b.x, nloc, nx); b.st[0] = nloc; b.st[1] = nx; }
        const unsigned old = xb_add(&bar[XB_XSUB(b.x)], 1u);
        const unsigned gen = old / nloc;
        if (old + 1u == (gen + 1u) * nloc) {
            __builtin_amdgcn_fence(__ATOMIC_RELEASE, "agent");
            asm volatile("s_waitcnt vmcnt(0)" ::: "memory");
            const unsigned og = xb_add(&bar[XB_TOP], 1u);
            const unsigned tg = og / nx;
            if (og + 1u == (tg + 1u) * nx) xb_add(&bar[XB_TOPGEN], 1u);
            else XB_SPIN(xb_ld(&bar[XB_TOPGEN]) == tg, bar);
            __builtin_amdgcn_fence(__ATOMIC_ACQUIRE, "agent");
            xb_add(&bar[XB_XGEN(b.x)], 1u);
            asm volatile("s_waitcnt vmcnt(0)" ::: "memory");
        } else {
            XB_SPIN(xb_ld(&bar[XB_XGEN(b.x)]) == gen, bar);
            __builtin_amdgcn_fence(__ATOMIC_ACQUIRE, "agent");
            asm volatile("s_waitcnt vmcnt(0)" ::: "memory");
        }
    }
    __syncthreads();
}

namespace pg8 {
constexpr int BM = 256, BK = 64, HALF = 128, HTB = HALF * BK * 2, STAGE_BYTES = 8 * HTB, NXCD = 8;
#ifndef WGM_D
#define WGM_D 4
#endif
#ifndef WGM_M
#define WGM_M 8
#endif
#ifndef WGM_QQ
#define WGM_QQ 4
#endif
constexpr int WGM = WGM_D, WGM_MOE = WGM_M, WGM_Q = WGM_QQ;
__host__ __device__ __forceinline__ int lds_byte(int r, int c) { const int st = (r >> 4) * 2 + (c >> 5), rr = r & 15, cc = c & 31, ob = rr * 64 + cc * 2; return st * 1024 + (ob ^ (((ob >> 9) & 1) << 5)); }
__host__ __device__ __forceinline__ void stage_rc(int b, int& R, int& C) { const int st = b / 1024, sb = b % 1024, swz = sb ^ (((sb >> 9) & 1) << 5); R = (st >> 1) * 16 + swz / 64; C = (st & 1) * 32 + (swz % 64) / 2; }
__host__ __device__ __forceinline__ int perm32(int rho) { const int n = rho >> 4, i = rho & 15; return 8 * (i >> 2) + 4 * n + (i & 3); }

struct Unit { const char* a; const char* b; int pm, pn, e, pad; };

__device__ __forceinline__ bool tile_of(long L, int nM, int nN, int& pm, int& pn, int wgm = WGM) {
    const int nwg = nM * nN; if (L >= nwg) return false;
    int wgid = (int)L; { const int q = nwg / NXCD, r = nwg % NXCD, xcd = wgid % NXCD, off = wgid / NXCD; wgid = (xcd < r ? xcd * (q + 1) : r * (q + 1) + (xcd - r) * q) + off; }
    const int nig = wgm * nN, gid = wgid / nig, fm = gid * wgm, gsz = (nM - fm) < wgm ? (nM - fm) : wgm;
    pm = fm + ((wgid % nig) % gsz); pn = (wgid % nig) / gsz; return true;
}
struct DenseOrder {
    const char* A; const char* Bt; int nM, nN, G, c, wgm = WGM; size_t tstep;
    __device__ __forceinline__ void init(const void* A_, const void* Bt_, int M, int N, int KB, int G_, int c_) { A = (const char*)A_; Bt = (const char*)Bt_; nM = M / BM; nN = N / BM; G = G_; c = c_; tstep = (size_t)BM * KB; }
    __device__ __forceinline__ bool next(int i, Unit& u) const {
        int pm, pn; if (!tile_of((long)i * G + c, nM, nN, pm, pn, wgm)) return false;
        u.pm = pm; u.pn = pn; u.e = 0; u.pad = 0; u.a = A + (size_t)pm * tstep; u.b = Bt + (size_t)pn * tstep; return true; }
    __device__ __forceinline__ void a_ready(const Unit&) const {}
    __device__ __forceinline__ void done(const Unit&) const {}
};
struct MoeOrder {
    const char* A; const char* Bt; const LAS int* tp; int nM, nN, G, c, wgm = WGM_MOE; size_t tstep, estep;
    int lim = 0x7fffffff;
    const int* rowtok = nullptr; LAS unsigned* ids = nullptr;
    __device__ __forceinline__ void init(const void* A_, const void* Bt_, const LAS int* tp_, int ntiles, int N, int KB, int G_, int c_) {
        A = (const char*)A_; Bt = (const char*)Bt_; tp = tp_; nM = ntiles; nN = N / BM; G = G_; c = c_; tstep = (size_t)BM * KB; estep = (size_t)N * KB; }
    __device__ __forceinline__ bool next(int i, Unit& u) const {
        int pm, pn; if ((long)i * G + c >= lim || !tile_of((long)i * G + c, nM, nN, pm, pn, wgm)) return false;
        const int lane = hw_lane(); const int v = (lane < 32) ? tp[lane + 1] : 0x7fffffff;
        const int e = __popcll(__ballot(v <= pm));
        u.pm = pm; u.pn = pn; u.e = e; u.pad = 0; u.a = rowtok ? A : A + (size_t)pm * tstep; u.b = Bt + (size_t)e * estep + (size_t)pn * tstep; return true; }
    __device__ __forceinline__ void a_ready(const Unit&) const {}
    __device__ __forceinline__ void done(const Unit&) const {}
};

struct MoeHalfOrder {
    const char* A; const char* Bt; const LAS int* tp; int nM, nN, c, l0, R, wgm = WGM_MOE, KB; size_t tstep, estep;
    __device__ __forceinline__ void init(const void* A_, const void* Bt_, const LAS int* tp_, int ntiles, int N, int KB_, int c_, int l0_, int R_) {
        A = (const char*)A_; Bt = (const char*)Bt_; tp = tp_; nM = ntiles; nN = N / BM; c = c_; l0 = l0_; R = R_; KB = KB_; tstep = (size_t)BM * KB_; estep = (size_t)N * KB_; }
    __device__ __forceinline__ bool next(int i, Unit& u) const {
        int pm, pn; if (i > 0 || c >= 2 * R || !tile_of((long)l0 + (c >> 1), nM, nN, pm, pn, wgm)) return false;
        const int lane = hw_lane(); const int v = (lane < 32) ? tp[lane + 1] : 0x7fffffff;
        const int e = __popcll(__ballot(v <= pm)), ro = (c & 1) * HALF;
        u.pm = pm; u.pn = pn; u.e = e; u.pad = ro; u.a = A + (size_t)pm * tstep + (size_t)ro * KB; u.b = Bt + (size_t)e * estep + (size_t)pn * tstep; return true; }
    __device__ __forceinline__ void a_ready(const Unit&) const {}
    __device__ __forceinline__ void done(const Unit&) const {}
};

struct QueueOrder {
    const char* A; const char* Bt; int nM, nN, nwg, per, x0, wave; size_t tstep; unsigned* head; volatile LAS unsigned* slot;
    mutable int k, seq;
    __device__ __forceinline__ void init(const void* A_, const void* Bt_, int M, int N, int KB, unsigned* head_, volatile LAS unsigned* slot_, int xcd, int wave_) {
        A = (const char*)A_; Bt = (const char*)Bt_; nM = M / BM; nN = N / BM; tstep = (size_t)BM * KB; slot = slot_; head = head_;
        nwg = nM * nN; per = (nwg + NXCD - 1) / NXCD; x0 = xcd & (NXCD - 1); k = 0; seq = 0; wave = wave_; }
    __device__ __forceinline__ bool next(int, Unit& u) const {
        int L;
        for (;;) {
            if (k >= NXCD) return false;
            const int q = (x0 + k) & (NXCD - 1), lo = q * per, hi = lo + per < nwg ? lo + per : nwg;
            if (wave == 0) {
                if (hw_lane() == 0) slot[seq & 1] = __hip_atomic_fetch_add(head + 64 * q, 1u, __ATOMIC_RELAXED, __HIP_MEMORY_SCOPE_AGENT);
                asm volatile("s_waitcnt vmcnt(0) lgkmcnt(0)" ::: "memory");
            }
            asm volatile("" ::: "memory"); __builtin_amdgcn_s_barrier(); asm volatile("" ::: "memory");
            L = lo + __builtin_amdgcn_readfirstlane((int)slot[seq & 1]); ++seq;
            if (L < hi) break;
            ++k;
        }
        const int nig = WGM_Q * nN, gid = L / nig, fm = gid * WGM_Q, gsz = (nM - fm) < WGM_Q ? (nM - fm) : WGM_Q;
        const int pm = fm + ((L % nig) % gsz), pn = (L % nig) / gsz;
        u.pm = pm; u.pn = pn; u.e = 0; u.pad = 0; u.a = A + (size_t)pm * tstep; u.b = Bt + (size_t)pn * tstep; return true; }
    __device__ __forceinline__ void a_ready(const Unit&) const {}
    __device__ __forceinline__ void done(const Unit&) const {}
};

typedef f32x4 Acc[2][2][4][2];
__device__ __forceinline__ f32x2 gelu_pk(f32x2 v) {
    const f32x2 av = __builtin_elementwise_abs(v), d = av * 0.2316418882f + 1.0f;
    f32x2 t; t.x = __builtin_amdgcn_rcpf(d.x); t.y = __builtin_amdgcn_rcpf(d.y);
    f32x2 q = t * 0.5307027145f + (-0.7265760135f); q = q * t + 0.7107068705f; q = q * t + (-0.142248368f); q = q * t + 0.127414796f; q = q * t;
    const f32x2 s = (v * v) * (-0.72134752044f);
    f32x2 e; e.x = __builtin_amdgcn_exp2f(s.x); e.y = __builtin_amdgcn_exp2f(s.y);
    const f32x2 m = v * (q * e), r = v - m;
    f32x2 o; o.x = v.x < 0.f ? m.x : r.x; o.y = v.y < 0.f ? m.y : r.y; return o;
}

__device__ __forceinline__ unsigned pk4_fp8(float a, float b, float c, float d) { int w = 0; w = __builtin_amdgcn_cvt_pk_fp8_f32(a, b, w, false); w = __builtin_amdgcn_cvt_pk_fp8_f32(c, d, w, true); return (unsigned)w; }
__device__ __forceinline__ float clamp448(float v) { return fminf(fmaxf(v, -448.0f), 448.0f); }
constexpr float SC_X1 = 16.0f, SC_WGU = 512.0f, SC_H = 4.0f, SC_WD = 1024.0f;
constexpr float SC_MRG = 16.0f, SC_WO = 1024.0f;
constexpr float SC_Y = 128.0f;
__device__ __forceinline__ float sat448(float v) { return __builtin_amdgcn_fmed3f(v, -448.0f, 448.0f); }
__device__ __forceinline__ float sat8(float v) { return __builtin_amdgcn_fmed3f(v * SC_MRG, -448.0f, 448.0f); }
struct EpiIn {
    struct Pre {}; __device__ __forceinline__ void prefetch(Pre&, const Unit&, int, int, int, int) const {}
    static constexpr bool PERM = true, AFTER_DRAIN = false;
    bf16 *QB, *KB, *VB, *ZB, *GT; const float* cs; int pn_off; float sc;
    __device__ __forceinline__ void operator()(const Acc& acc, const Unit& u, int wr, int wc, int fr, int fq, const Pre&) const {
        const int pn = (pn_off == 0 && u.pn >= 18) ? u.pn + 8 : u.pn + pn_off; bf16* base; int ldc, colt, mode;
        if (pn < 6) { base = QB; ldc = AW; colt = 256 * pn; mode = 1; }
        else if (pn < 12) { base = KB; ldc = AW; colt = 256 * (pn - 6); mode = 1; }
        else if (pn < 18) { base = VB; ldc = AW; colt = 256 * (pn - 12); mode = 0; }
        else if (pn < 26) { base = ZB; ldc = 2048; colt = 256 * (pn - 18); mode = 2; }
        else { base = GT; ldc = 4096; colt = 256 * (pn - 26); mode = 3; }
        const int row0 = u.pm * BM + wr * 64 + fr, col0 = colt + wc * 32 + 8 * fq;
        const bool rope = (mode == 1) && (wc == 0);
#pragma unroll
        for (int ai = 0; ai < 2; ++ai)
#pragma unroll
            for (int m = 0; m < 4; ++m) {
                const int row = row0 + ai * HALF + m * 16;
                f32x4 cs4[4];
                if (rope) { const f32x4* cp = (const f32x4*)(cs + ((size_t)row * 16 + 8 * (fq & 1)) * 2);
#pragma unroll
                    for (int q = 0; q < 4; ++q) cs4[q] = cp[q]; }
                bf16* rowp = base + (size_t)row * ldc + col0;
#pragma unroll
                for (int bj = 0; bj < 2; ++bj) {
                    f32x4 v0 = acc[ai][bj][m][0] * sc, v1 = acc[ai][bj][m][1] * sc;
                    if (rope) {
                        float x[8] = {v0[0], v0[1], v0[2], v0[3], v1[0], v1[1], v1[2], v1[3]};
#pragma unroll
                        for (int i = 0; i < 8; ++i) {
                            const float y = __shfl_xor(x[i], 32);
                            const float c = cs4[i >> 1][(i & 1) * 2], s = cs4[i >> 1][(i & 1) * 2 + 1];
                            x[i] = (fq < 2) ? (x[i] * c - y * s) : (x[i] * c + y * s);
                        }
                        v0 = (f32x4){x[0], x[1], x[2], x[3]}; v1 = (f32x4){x[4], x[5], x[6], x[7]};
                    }
                    if (mode == 2) { f32x2 a = gelu_pk((f32x2){v0[0], v0[1]}), b = gelu_pk((f32x2){v0[2], v0[3]}), c = gelu_pk((f32x2){v1[0], v1[1]}), d = gelu_pk((f32x2){v1[2], v1[3]});
                        v0 = (f32x4){a.x, a.y, b.x, b.y}; v1 = (f32x4){c.x, c.y, d.x, d.y}; }
                    if (mode == 3) {
                        const float ce = -1.44269504089f * sc;
                        const f32x4 a0 = acc[ai][bj][m][0], a1 = acc[ai][bj][m][1];
                        const f32x2 e0 = (f32x2){a0[0], a0[1]} * ce, e1 = (f32x2){a0[2], a0[3]} * ce, e2 = (f32x2){a1[0], a1[1]} * ce, e3 = (f32x2){a1[2], a1[3]} * ce;
                        f32x2 t0, t1, t2, t3;
                        t0.x = __builtin_amdgcn_exp2f(e0.x); t0.y = __builtin_amdgcn_exp2f(e0.y); t1.x = __builtin_amdgcn_exp2f(e1.x); t1.y = __builtin_amdgcn_exp2f(e1.y);
                        t2.x = __builtin_amdgcn_exp2f(e2.x); t2.y = __builtin_amdgcn_exp2f(e2.y); t3.x = __builtin_amdgcn_exp2f(e3.x); t3.y = __builtin_amdgcn_exp2f(e3.y);
                        t0 = t0 + 1.0f; t1 = t1 + 1.0f; t2 = t2 + 1.0f; t3 = t3 + 1.0f;
                        v0 = (f32x4){__builtin_amdgcn_rcpf(t0.x), __builtin_amdgcn_rcpf(t0.y), __builtin_amdgcn_rcpf(t1.x), __builtin_amdgcn_rcpf(t1.y)};
                        v1 = (f32x4){__builtin_amdgcn_rcpf(t2.x), __builtin_amdgcn_rcpf(t2.y), __builtin_amdgcn_rcpf(t3.x), __builtin_amdgcn_rcpf(t3.y)}; }
                    u32x4 w; w.x = cvt_pk_bf16(v0[0], v0[1]); w.y = cvt_pk_bf16(v0[2], v0[3]); w.z = cvt_pk_bf16(v1[0], v1[1]); w.w = cvt_pk_bf16(v1[2], v1[3]);
                    *(u32x4*)(rowp + bj * HALF) = w;
                }
            }
    }
};
template <bool OUT8>
struct EpiGateT {
    struct Pre {}; __device__ __forceinline__ void prefetch(Pre&, const Unit&, int, int, int, int) const {}
    static constexpr bool PERM = true, AFTER_DRAIN = false;
    bf16* MRG; const bf16* GT; int goff; int accum; unsigned char* MRG8;
    __device__ __forceinline__ void operator()(const Acc& acc, const Unit& u, int wr, int wc, int fr, int fq, const Pre&) const {
        const int row0 = u.pm * BM + wr * 64 + fr, col0 = u.pn * BM + wc * 32 + 8 * fq;
#pragma unroll
        for (int ai = 0; ai < 2; ++ai)
#pragma unroll
            for (int m = 0; m < 4; ++m) {
                const int row = row0 + ai * HALF + m * 16;
#pragma unroll
                for (int bj = 0; bj < 2; ++bj) {
                    const int col = col0 + bj * HALF;
                    const u32x4 g = *(const u32x4*)(GT + (size_t)row * 4096 + goff + col);
                    bf16* op = MRG + (size_t)row * D + col;
                    f32x4 v0 = acc[ai][bj][m][0], v1 = acc[ai][bj][m][1];
                    v0[0] *= bflo(g.x); v0[1] *= bfhi(g.x); v0[2] *= bflo(g.y); v0[3] *= bfhi(g.y);
                    v1[0] *= bflo(g.z); v1[1] *= bfhi(g.z); v1[2] *= bflo(g.w); v1[3] *= bfhi(g.w);
                    if (accum) { const u32x4 o = *(const u32x4*)op;
                        v0[0] += bflo(o.x); v0[1] += bfhi(o.x); v0[2] += bflo(o.y); v0[3] += bfhi(o.y);
                        v1[0] += bflo(o.z); v1[1] += bfhi(o.z); v1[2] += bflo(o.w); v1[3] += bfhi(o.w); }
                    if constexpr (OUT8) {
                        u32x2 w; w.x = pk4_fp8(sat8(v0[0]), sat8(v0[1]), sat8(v0[2]), sat8(v0[3])); w.y = pk4_fp8(sat8(v1[0]), sat8(v1[1]), sat8(v1[2]), sat8(v1[3]));
                        *(u32x2*)(MRG8 + (size_t)row * D + col) = w; }
                    else { u32x4 w; w.x = cvt_pk_bf16(v0[0], v0[1]); w.y = cvt_pk_bf16(v0[2], v0[3]); w.z = cvt_pk_bf16(v1[0], v1[1]); w.w = cvt_pk_bf16(v1[2], v1[3]);
                        *(u32x4*)op = w; }
                }
            }
    }
};
struct EpiX1 {
    struct Pre {}; __device__ __forceinline__ void prefetch(Pre&, const Unit&, int, int, int, int) const {}
    static constexpr bool PERM = true, AFTER_DRAIN = false;
    const bf16* xb; bf16* X1F; float sc;
    __device__ __forceinline__ void operator()(const Acc& acc, const Unit& u, int wr, int wc, int fr, int fq, const Pre&) const {
        const int row0 = u.pm * BM + wr * 64 + fr, col0 = u.pn * BM + wc * 32 + 8 * fq;
#pragma unroll
        for (int ai = 0; ai < 2; ++ai)
#pragma unroll
            for (int m = 0; m < 4; ++m) { const size_t off = (size_t)(row0 + ai * HALF + m * 16) * D + col0;
#pragma unroll
                for (int bj = 0; bj < 2; ++bj) { const u32x4 xv = *(const u32x4*)(xb + off + bj * HALF);
                    f32x4 v0 = acc[ai][bj][m][0] * sc, v1 = acc[ai][bj][m][1] * sc;
                    v0[0] += ALPHA * bflo(xv.x); v0[1] += ALPHA * bfhi(xv.x); v0[2] += ALPHA * bflo(xv.y); v0[3] += ALPHA * bfhi(xv.y);
                    v1[0] += ALPHA * bflo(xv.z); v1[1] += ALPHA * bfhi(xv.z); v1[2] += ALPHA * bflo(xv.w); v1[3] += ALPHA * bfhi(xv.w);
                    u32x4 w; w.x = cvt_pk_bf16(v0[0], v0[1]); w.y = cvt_pk_bf16(v0[2], v0[3]); w.z = cvt_pk_bf16(v1[0], v1[1]); w.w = cvt_pk_bf16(v1[2], v1[3]);
                    *(u32x4*)(X1F + off + bj * HALF) = w; } }
    }
};
struct EpiSwiglu8 {
    struct Pre { f32x4 bg0, bg1, bu0, bu1; };
    static constexpr bool PERM = true, AFTER_DRAIN = false;
    unsigned char* HB8; const float* bgu;
    __device__ __forceinline__ void prefetch(Pre& P, const Unit& u, int wr, int wc, int fr, int fq) const {
        const float* bg = bgu + (size_t)u.e * (2 * DE) + u.pn * HALF + wc * 32 + 8 * fq;
        P.bg0 = *(const f32x4*)bg; P.bg1 = *(const f32x4*)(bg + 4); P.bu0 = *(const f32x4*)(bg + DE); P.bu1 = *(const f32x4*)(bg + DE + 4); }
    __device__ __forceinline__ void operator()(const Acc& acc, const Unit& u, int wr, int wc, int fr, int fq, const Pre& P) const {
        const int row0 = u.pm * BM + wr * 64 + fr, ch0 = u.pn * HALF + wc * 32 + 8 * fq;
        const float isc = 1.0f / (SC_X1 * SC_WGU), ce = -1.702f * 1.44269504089f, qh = 1.0f / SC_H;
        const f32x2 bg[4] = {(f32x2){P.bg0[0], P.bg0[1]}, (f32x2){P.bg0[2], P.bg0[3]}, (f32x2){P.bg1[0], P.bg1[1]}, (f32x2){P.bg1[2], P.bg1[3]}};
        const f32x2 bu[4] = {(f32x2){P.bu0[0] + 1.0f, P.bu0[1] + 1.0f}, (f32x2){P.bu0[2] + 1.0f, P.bu0[3] + 1.0f}, (f32x2){P.bu1[0] + 1.0f, P.bu1[1] + 1.0f}, (f32x2){P.bu1[2] + 1.0f, P.bu1[3] + 1.0f}};
#pragma unroll
        for (int ai = 0; ai < 2; ++ai)
#pragma unroll
            for (int m = 0; m < 4; ++m) {
                const int row = row0 + ai * HALF + m * 16;
                f32x2 h[4];
#pragma unroll
                for (int p = 0; p < 4; ++p) {
                    const f32x4 ag = acc[ai][0][m][p >> 1], au = acc[ai][1][m][p >> 1];
                    f32x2 g = (f32x2){ag[2 * (p & 1)], ag[2 * (p & 1) + 1]} * isc + bg[p];
                    f32x2 u1 = (f32x2){au[2 * (p & 1)], au[2 * (p & 1) + 1]} * isc + bu[p];
                    g = __builtin_elementwise_min(g, (f32x2){7.0f, 7.0f});
                    u1 = __builtin_elementwise_min(__builtin_elementwise_max(u1, (f32x2){-6.0f, -6.0f}), (f32x2){8.0f, 8.0f});
                    const f32x2 ge = g * ce;
                    f32x2 t; t.x = __builtin_amdgcn_exp2f(ge.x); t.y = __builtin_amdgcn_exp2f(ge.y);
                    const f32x2 d = t * qh + qh;
                    f32x2 s; s.x = __builtin_amdgcn_rcpf(d.x); s.y = __builtin_amdgcn_rcpf(d.y);
                    h[p] = (u1 * g) * s;
                }
                u32x2 w; w.x = pk4_fp8(h[0].x, h[0].y, h[1].x, h[1].y); w.y = pk4_fp8(h[2].x, h[2].y, h[3].x, h[3].y);
                *(u32x2*)(HB8 + (size_t)row * DE + ch0) = w;
            }
    }
};
struct EpiDown {
    struct Pre {};
    static constexpr bool PERM = true, AFTER_DRAIN = false;
    unsigned char* YB; const float* bd; const float* rgate; float isc; LAS float* epi;
    __device__ __forceinline__ void prefetch(Pre&, const Unit& u, int wr, int wc, int fr, int fq) const {
        const int wid = wr * 4 + wc, lane = fq * 16 + fr;
        const float* src = (wid < 4) ? (rgate + u.pm * BM + u.pad + 64 * wid + lane) : (bd + (size_t)u.e * D + u.pn * BM + 64 * (wid - 4) + lane);
        __builtin_amdgcn_global_load_lds((const unsigned*)src, (LAS unsigned*)(epi + 64 * wid), 4, 0, 0);
    }
    __device__ __forceinline__ void operator()(const Acc& acc, const Unit& u, int wr, int wc, int fr, int fq, const Pre& p) const { run<2>(acc, u, wr, wc, fr, fq, p); }
    __device__ __forceinline__ void half(const Acc& acc, const Unit& u, int wr, int wc, int fr, int fq, const Pre& p) const { run<1>(acc, u, wr, wc, fr, fq, p); }
    template <int NAI>
    __device__ __forceinline__ void run(const Acc& acc, const Unit& u, int wr, int wc, int fr, int fq, const Pre&) const {
        const int row0 = u.pm * BM + u.pad + wr * 64 + fr, col0 = u.pn * BM + wc * 32 + 8 * fq;
        f32x4 bv[2][2];
#pragma unroll
        for (int bj = 0; bj < 2; ++bj)
#pragma unroll
            for (int n = 0; n < 2; ++n) bv[bj][n] = *(const LAS f32x4*)(epi + 256 + wc * 32 + 8 * fq + bj * HALF + 4 * n);
#pragma unroll
        for (int ai = 0; ai < NAI; ++ai)
#pragma unroll
            for (int m = 0; m < 4; ++m) {
                const int row = row0 + ai * HALF + m * 16; const float gt = epi[wr * 64 + fr + ai * HALF + m * 16] * SC_Y;
#pragma unroll
                for (int bj = 0; bj < 2; ++bj) {
                    const f32x4 v0 = (acc[ai][bj][m][0] * isc + bv[bj][0]) * gt, v1 = (acc[ai][bj][m][1] * isc + bv[bj][1]) * gt;
                    u32x2 w; w.x = pk4_fp8(sat448(v0[0]), sat448(v0[1]), sat448(v0[2]), sat448(v0[3])); w.y = pk4_fp8(sat448(v1[0]), sat448(v1[1]), sat448(v1[2]), sat448(v1[3]));
                    *(u32x2*)(YB + (size_t)row * D + col0 + bj * HALF) = w;
                }
            }
    }
};

typedef int i32x8 __attribute__((ext_vector_type(8)));
typedef short s16x16 __attribute__((ext_vector_type(16)));
typedef int i32x4 __attribute__((ext_vector_type(4)));
__device__ __forceinline__ bf16x8 lo8(i32x8 v) { return __builtin_bit_cast(bf16x8, __builtin_shufflevector(v, v, 0, 1, 2, 3)); }
__device__ __forceinline__ bf16x8 hi8(i32x8 v) { return __builtin_bit_cast(bf16x8, __builtin_shufflevector(v, v, 4, 5, 6, 7)); }
__device__ __forceinline__ void mfma_fp8(f32x4& c, const i32x8& a, const i32x8& b) { asm volatile("v_mfma_f32_16x16x128_f8f6f4 %0, %1, %2, %0" : "+v"(c) : "v"(a), "v"(b)); }
template <class Epi, class Sched, bool FP8 = false, bool ALIGN_EPI = true, bool GATHER = false, bool HALFM = false>
__device__ __forceinline__ void gemm_phase(LAS unsigned char* lds, const int KB, const Sched& S, const Epi& E, const int wave) {
    const int lane = hw_lane(), wid = wave, tid = wid * 64 + lane,
              wr = wid >> 2, wc = wid & 3, fr = lane & 15, fq = lane >> 4;
    const int nt = KB / 128;
    unsigned voffA[2], voffB[2];
#pragma unroll
    for (int i = 0; i < 2; ++i) { int R, C; stage_rc(tid * 16 + i * 8192, R, C); const int Rb = Epi::PERM ? ((R & ~31) + perm32(R & 31)) : R;
        voffA[i] = (unsigned)(R * KB + C * 2); voffB[i] = (unsigned)(Rb * KB + C * 2); }
    const size_t kstep = (size_t)(BK * 2);
    const size_t hstep = (size_t)HALF * KB;
    const unsigned ldsw = (unsigned)wid * 1024u;
    const int aoff = lds_byte(wr * 64 + fr, fq * 8), boff = lds_byte(wc * 32 + fr, fq * 8);
#define PG8_SA(b, h) (((b) * 2 + (h)) * HTB)
#define PG8_SB(b, h) ((4 + (b) * 2 + (h)) * HTB)
#define PG8_STAGE(bufoff, gbase, voff) do { _Pragma("unroll") for (int _i = 0; _i < 2; ++_i) \
        __builtin_amdgcn_global_load_lds((const unsigned*)((const char*)(gbase) + (voff)[_i]), (LAS unsigned*)(lds + (bufoff) + ldsw + _i * 8192), 16, 0, 0); } while (0)
#define PG8_STA(bufoff, kp, h) do { if constexpr (GATHER) { _Pragma("unroll") for (int _i = 0; _i < 2; ++_i) \
        __builtin_amdgcn_global_load_lds((const unsigned*)((const char*)(kp) + gc[h][_i]), (LAS unsigned*)(lds + (bufoff) + ldsw + _i * 8192), 16, 0, 0); } \
        else { PG8_STAGE(bufoff, (kp) + (h) * hstep, voffA); } } while (0)
#define PG8_GFETCH(u) do { if constexpr (GATHER) { if (wid < 4) __builtin_amdgcn_global_load_lds((const unsigned*)(S.rowtok + (u).pm * BM + 64 * wid + lane), (LAS unsigned*)(S.ids + 64 * wid), 4, 0, 0); } } while (0)
#define PG8_GREAD() do { if constexpr (GATHER) { _Pragma("unroll") for (int _h = 0; _h < 2; ++_h) _Pragma("unroll") for (int _i = 0; _i < 2; ++_i) { int R_, C_; stage_rc(tid * 16 + _i * 8192, R_, C_); \
        gc[_h][_i] = S.ids[_h * HALF + R_] * (unsigned)KB + (unsigned)(C_ * 2); } } } while (0)
#define PG8_LDA(dst, b, h) do { _Pragma("unroll") for (int m = 0; m < 4; ++m) { const i32x4 _l = *(const LAS i32x4*)(lds + PG8_SA(b, h) + aoff + m * 2048), _h = *(const LAS i32x4*)(lds + PG8_SA(b, h) + aoff + m * 2048 + 1024); \
        dst[m] = __builtin_shufflevector(_l, _h, 0, 1, 2, 3, 4, 5, 6, 7); } } while (0)
#define PG8_LDB(dst, b, h) do { _Pragma("unroll") for (int n = 0; n < 2; ++n) { const i32x4 _l = *(const LAS i32x4*)(lds + PG8_SB(b, h) + boff + n * 2048), _h = *(const LAS i32x4*)(lds + PG8_SB(b, h) + boff + n * 2048 + 1024); \
        dst[n] = __builtin_shufflevector(_l, _h, 0, 1, 2, 3, 4, 5, 6, 7); } } while (0)
#define PG8_MMA(ai, bj, At, Bt) do { __builtin_amdgcn_s_setprio(1); _Pragma("unroll") for (int m = 0; m < 4; ++m) _Pragma("unroll") for (int n = 0; n < 2; ++n) { \
        if constexpr (FP8) { mfma_fp8(acc[ai][bj][m][n], Bt[n], At[m]); } \
        else { acc[ai][bj][m][n] = __builtin_amdgcn_mfma_f32_16x16x32_bf16(lo8(Bt[n]), lo8(At[m]), acc[ai][bj][m][n], 0, 0, 0); \
               acc[ai][bj][m][n] = __builtin_amdgcn_mfma_f32_16x16x32_bf16(hi8(Bt[n]), hi8(At[m]), acc[ai][bj][m][n], 0, 0, 0); } } __builtin_amdgcn_s_setprio(0); } while (0)
#define PG8_WAIT_V(n) asm volatile("s_waitcnt vmcnt(" #n ")" ::: "memory")
#define PG8_WAIT_L(n) asm volatile("s_waitcnt lgkmcnt(" #n ")" ::: "memory")
#define PG8_BAR __builtin_amdgcn_s_barrier()
#define PG8_SCHED __builtin_amdgcn_sched_barrier(0)
    Unit cur, nxt; int ui = 0;
    if (!S.next(0, cur)) return;
    f32x4 acc[2][2][4][2];
#pragma unroll
    for (int a = 0; a < 2; ++a)
#pragma unroll
        for (int b = 0; b < 2; ++b)
#pragma unroll
            for (int m = 0; m < 4; ++m)
#pragma unroll
                for (int n = 0; n < 2; ++n) acc[a][b][m][n] = (f32x4){0.f, 0.f, 0.f, 0.f};
    typename Epi::Pre pre;
    i32x8 At[4], B0[2], B1[2];
    const char* cA = cur.a; const char* cB = cur.b;
    S.a_ready(cur);
    unsigned gc[2][2] = {{0u, 0u}, {0u, 0u}};
    if constexpr (GATHER) { PG8_GFETCH(cur); PG8_WAIT_V(0); PG8_BAR; PG8_GREAD(); PG8_WAIT_L(0); PG8_BAR; }
    PG8_STAGE(PG8_SB(0, 0), cB, voffB); PG8_STAGE(PG8_SB(0, 1), cB + hstep, voffB); PG8_STA(PG8_SA(0, 0), cA, 0); PG8_STA(PG8_SA(0, 1), cA, 1);
    if (wr == 1) PG8_BAR;
    PG8_WAIT_V(2); PG8_BAR;
    PG8_STAGE(PG8_SB(1, 0), cB + kstep, voffB); PG8_STA(PG8_SA(1, 0), cA + kstep, 0); PG8_STAGE(PG8_SB(1, 1), cB + hstep + kstep, voffB);
    PG8_WAIT_V(6); PG8_BAR;
    for (;;) {
        const bool has_next = S.next(ui + 1, nxt);
        const char* nA = has_next ? nxt.a : cA; const char* nB = has_next ? nxt.b : cB;
        if (has_next) PG8_GFETCH(nxt);
        for (int t = 0; t < nt; t += 2) {
            const bool last = (t == nt - 2);
            const char* a1 = cA + (size_t)(t + 1) * kstep;
            const char* a2 = last ? nA : cA + (size_t)(t + 2) * kstep; const char* b2 = last ? nB : cB + (size_t)(t + 2) * kstep;
            const char* a3 = a2 + kstep; const char* b3 = b2 + kstep;
            if (last && has_next) S.a_ready(nxt);
            if (last) E.prefetch(pre, cur, wr, wc, fr, fq);
            PG8_LDB(B0, 0, 0); PG8_LDB(B1, 0, 1); PG8_SCHED; PG8_LDA(At, 0, 0); PG8_STA(PG8_SA(1, 1), a1, 1);
            if constexpr (GATHER) { if (last && has_next) PG8_GREAD(); }
            PG8_WAIT_V(8); PG8_WAIT_L(0); PG8_BAR; PG8_MMA(0, 0, At, B0); PG8_MMA(0, 1, At, B1); PG8_BAR; PG8_SCHED;
            if constexpr (!HALFM) PG8_LDA(At, 0, 1); PG8_STAGE(PG8_SB(0, 0), b2, voffB); PG8_STAGE(PG8_SB(0, 1), b2 + hstep, voffB); PG8_STA(PG8_SA(0, 0), a2, 0);
            PG8_WAIT_V(8); PG8_WAIT_L(0); PG8_BAR; if constexpr (!HALFM) { PG8_MMA(1, 0, At, B0); PG8_MMA(1, 1, At, B1); } PG8_BAR; PG8_SCHED;
            PG8_LDB(B0, 1, 0); PG8_LDB(B1, 1, 1); PG8_SCHED; PG8_LDA(At, 1, 0); PG8_STA(PG8_SA(0, 1), a2, 1);
            PG8_WAIT_V(8); PG8_WAIT_L(0); PG8_BAR; PG8_MMA(0, 0, At, B0); PG8_MMA(0, 1, At, B1); PG8_BAR; PG8_SCHED;
            if constexpr (!HALFM) PG8_LDA(At, 1, 1); PG8_STAGE(PG8_SB(1, 0), b3, voffB); PG8_STAGE(PG8_SB(1, 1), b3 + hstep, voffB); PG8_STA(PG8_SA(1, 0), a3, 0);
            PG8_WAIT_V(8); PG8_WAIT_L(0); PG8_BAR; if constexpr (!HALFM) { PG8_MMA(1, 0, At, B0); PG8_MMA(1, 1, At, B1); } PG8_BAR; PG8_SCHED;
        }
        if constexpr (ALIGN_EPI) { if (wr == 0) PG8_BAR; }
        { const int te = hw_lane();
          if constexpr (HALFM) E.half(acc, cur, wr, wc, te & 15, te >> 4, pre); else E(acc, cur, wr, wc, te & 15, te >> 4, pre); } S.done(cur);
        if (!has_next) break;
#pragma unroll
        for (int a = 0; a < 2; ++a)
#pragma unroll
            for (int b = 0; b < 2; ++b)
#pragma unroll
                for (int m = 0; m < 4; ++m)
#pragma unroll
                    for (int n = 0; n < 2; ++n) acc[a][b][m][n] = (f32x4){0.f, 0.f, 0.f, 0.f};
        cur = nxt; cA = nA; cB = nB; ++ui;
        if constexpr (ALIGN_EPI) { if (wr == 1) PG8_BAR; }
    }
    PG8_WAIT_V(0);
    if constexpr (!ALIGN_EPI) { if (wr == 0) PG8_BAR; }
    PG8_BAR;
#undef PG8_SA
#undef PG8_SB
#undef PG8_STAGE
#undef PG8_LDA
#undef PG8_STA
#undef PG8_GFETCH
#undef PG8_GREAD
#undef PG8_LDB
#undef PG8_MMA
#undef PG8_WAIT_V
#undef PG8_WAIT_L
#undef PG8_BAR
#undef PG8_SCHED
}
}

struct Args { const void* in[20]; float* out; unsigned char* ws; int ph_lo, ph_hi; };
struct Frame {
    LAS unsigned char* lds;
    int tid, lane, wave, G, bx;
    int c, GG;
    unsigned char* ws;
    unsigned* ctl;
};
#define WSP(T, off) ((T*)(F.ws + (off)))
#define B_XB WSP(bf16, WS_XB)
#define B_WIN WSP(bf16, WS_WIN)
#define B_WA WSP(bf16, WS_WA)
#define B_WB WSP(bf16, WS_WB)
#define B_WO WSP(bf16, WS_WO)
#define B_WGU8 WSP(unsigned char, WS_WGU)
#define B_WD8 WSP(unsigned char, WS_WD)
#define B_SGW WSP(bf16, WS_SGW)
#define B_CS WSP(float, WS_CS)
#define B_WRT WSP(bf16, WS_WRT)
#define B_X8 WSP(unsigned char, WS_X8)
#define B_WIN8 WSP(unsigned char, WS_WIN8)
#define B_VST WSP(float, WS_VST)
#define B_QB WSP(bf16, WS_QB)
#define B_KB WSP(bf16, WS_KB)
#define B_VB WSP(bf16, WS_VB)
#define B_ZB WSP(bf16, WS_ZB)
#define B_GT WSP(bf16, WS_GT)
#define B_OG WSP(bf16, WS_OG)
#define B_LSE WSP(float, WS_LSE)
#define B_OA WSP(bf16, WS_OA)
#define B_SGI WSP(bf16, WS_SGI)
#define B_MRG WSP(bf16, WS_MRG)
#define B_X1F WSP(bf16, WS_X1F)
#define B_X1Q WSP(unsigned char, WS_X1B)
#define B_MRG8 WSP(unsigned char, WS_X1B + 32 * MiB)
#define B_WO8 WSP(unsigned char, WS_WO)
#define B_LN1ST WSP(float, WS_VST)
#define B_X1H WSP(bf16, WS_MRG)
#define B_CNTWG WSP(int, WS_STOK)
#define B_TGATE WSP(float, WS_SGATE)
#define B_INV WSP(int, WS_INV)
#define B_RGATE WSP(float, WS_RGATE)
#define B_ROWTOK WSP(int, WS_STOK + 1 * MiB)
#define B_TPG WSP(int, WS_RGATE + 512 * 1024)
#define B_XS8 WSP(unsigned char, WS_XS)
#define B_HB8 WSP(unsigned char, WS_HB)
#define B_YB WSP(unsigned char, WS_YB)

__device__ __forceinline__ unsigned off_b(unsigned row, unsigned ch) { return 256u * row + 16u * (ch ^ (((row & 3) << 2) | ((row >> 2) & 3))); }
__device__ __forceinline__ unsigned tr_addr16(unsigned lane, unsigned c, unsigned ks, unsigned t) {
    const unsigned g = lane >> 4, q = (lane & 15) >> 2, p = lane & 3;
    return off_b(32 * ks + 8 * g + 4 * t + q, 2 * c + (p >> 1)) + 8 * (p & 1);
}
template <int OFF>
__device__ __forceinline__ bf16x8 tr_read2(unsigned a0, unsigned a1) {
    s16x4 lo, hi;
    asm volatile("ds_read_b64_tr_b16 %0, %2 offset:%4\n\tds_read_b64_tr_b16 %1, %3 offset:%4\n\ts_waitcnt lgkmcnt(0)" : "=&v"(lo), "=&v"(hi) : "v"(a0), "v"(a1), "i"(OFF) : "memory");
    bf16x8 r; r[0] = lo[0]; r[1] = lo[1]; r[2] = lo[2]; r[3] = lo[3]; r[4] = hi[0]; r[5] = hi[1]; r[6] = hi[2]; r[7] = hi[3]; return r;
}

template <int OFF>
__device__ __forceinline__ void tr_read16(const unsigned (&a)[8][2], bf16x8 (&f)[8]) {
    s16x4 r[16];
    asm volatile("ds_read_b64_tr_b16 %0, %16 offset:%32\n\tds_read_b64_tr_b16 %1, %17 offset:%32\n\tds_read_b64_tr_b16 %2, %18 offset:%32\n\tds_read_b64_tr_b16 %3, %19 offset:%32\n\t"
                 "ds_read_b64_tr_b16 %4, %20 offset:%32\n\tds_read_b64_tr_b16 %5, %21 offset:%32\n\tds_read_b64_tr_b16 %6, %22 offset:%32\n\tds_read_b64_tr_b16 %7, %23 offset:%32\n\t"
                 "ds_read_b64_tr_b16 %8, %24 offset:%32\n\tds_read_b64_tr_b16 %9, %25 offset:%32\n\tds_read_b64_tr_b16 %10, %26 offset:%32\n\tds_read_b64_tr_b16 %11, %27 offset:%32\n\t"
                 "ds_read_b64_tr_b16 %12, %28 offset:%32\n\tds_read_b64_tr_b16 %13, %29 offset:%32\n\tds_read_b64_tr_b16 %14, %30 offset:%32\n\tds_read_b64_tr_b16 %15, %31 offset:%32\n\ts_waitcnt lgkmcnt(0)"
                 : "=&v"(r[0]), "=&v"(r[1]), "=&v"(r[2]), "=&v"(r[3]), "=&v"(r[4]), "=&v"(r[5]), "=&v"(r[6]), "=&v"(r[7]), "=&v"(r[8]), "=&v"(r[9]), "=&v"(r[10]), "=&v"(r[11]), "=&v"(r[12]), "=&v"(r[13]), "=&v"(r[14]), "=&v"(r[15])
                 : "v"(a[0][0]), "v"(a[0][1]), "v"(a[1][0]), "v"(a[1][1]), "v"(a[2][0]), "v"(a[2][1]), "v"(a[3][0]), "v"(a[3][1]), "v"(a[4][0]), "v"(a[4][1]), "v"(a[5][0]), "v"(a[5][1]), "v"(a[6][0]), "v"(a[6][1]), "v"(a[7][0]), "v"(a[7][1]), "i"(OFF)
                 : "memory");
#pragma unroll
    for (int c = 0; c < 8; ++c) { bf16x8 t; t[0] = r[2 * c][0]; t[1] = r[2 * c][1]; t[2] = r[2 * c][2]; t[3] = r[2 * c][3]; t[4] = r[2 * c + 1][0]; t[5] = r[2 * c + 1][1]; t[6] = r[2 * c + 1][2]; t[7] = r[2 * c + 1][3]; f[c] = t; }
}

__device__ __forceinline__ void p0_transpose_item(const float* W, int K, int N, bf16* WT, int k0, int n0, int drow0, LAS float* scr, int lane) {
#pragma unroll 8
    for (int i = 0; i < 32; ++i) { const int kk = 2 * i + (lane >> 5); scr[kk * 33 + (lane & 31)] = W[(size_t)(k0 + kk) * N + n0 + (lane & 31)]; }
    asm volatile("s_waitcnt lgkmcnt(0)" ::: "memory");
    const int c = lane & 7;
#pragma unroll
    for (int j = 0; j < 4; ++j) { const int n = (lane >> 3) + 8 * j; const LAS float* s = scr + (8 * c) * 33 + n;
        u32x4 o; o.x = cvt_pk_bf16(s[0 * 33], s[1 * 33]); o.y = cvt_pk_bf16(s[2 * 33], s[3 * 33]); o.z = cvt_pk_bf16(s[4 * 33], s[5 * 33]); o.w = cvt_pk_bf16(s[6 * 33], s[7 * 33]);
        *(u32x4*)(WT + (size_t)(drow0 + n) * K + k0 + 8 * c) = o; }
    asm volatile("s_waitcnt lgkmcnt(0)" ::: "memory");
}
constexpr int N8E = NE * ((D / 128) * (2 * DE / 32) + (DE / 128) * (D / 32));
constexpr int N8Q = N8E + (D / 128) * ((3 * AW + 2 * D) / 32);
constexpr int N8 = N8Q + (D / 128) * (D / 32);
struct P0Item { const float* src; unsigned char* dst; int N, K; float scale; };
__device__ __forceinline__ void p0_item8_decode(const Args& args, Frame& F, int it, P0Item& I) {
    constexpr int I_GU1 = (D / 128) * (2 * DE / 32);
    constexpr int I_D1 = (DE / 128) * (D / 32);
    if (it < NE * I_GU1) { const int e = it / I_GU1, q = it % I_GU1, nb = 2 * DE / 32, n0 = 32 * (q % nb), k0 = 128 * (q / nb);
        const int bj = n0 / DE, rem = n0 % DE, drow0 = 256 * (rem / 128) + 128 * bj + (rem % 128);
        I.src = ((const float*)args.in[14]) + (size_t)e * D * 2 * DE + (size_t)k0 * (2 * DE) + n0; I.dst = B_WGU8 + (size_t)e * 2 * DE * D + (size_t)drow0 * D + k0; I.N = 2 * DE; I.K = D; I.scale = pg8::SC_WGU; }
    else if (it < NE * (I_GU1 + I_D1)) { const int r = it - NE * I_GU1; const int e = r / I_D1, q = r % I_D1, nb = D / 32, n0 = 32 * (q % nb), k0 = 128 * (q / nb);
        I.src = ((const float*)args.in[16]) + (size_t)e * DE * D + (size_t)k0 * D + n0; I.dst = B_WD8 + (size_t)e * D * DE + (size_t)n0 * DE + k0; I.N = D; I.K = DE; I.scale = pg8::SC_WD; }
    else if (it >= N8Q) { const int q = it - N8Q, nb = D / 32, n0 = 32 * (q % nb), k0 = 128 * (q / nb);
        I.src = ((const float*)args.in[9]) + (size_t)k0 * D + n0; I.dst = B_WO8 + (size_t)n0 * D + k0; I.N = D; I.K = D; I.scale = pg8::SC_WO; }
    else { const int q = it - NE * (I_GU1 + I_D1), nb = (3 * AW + 2 * D) / 32, r0 = 32 * (q % nb), k0 = 128 * (q / nb);
        const int n0 = r0 < 3 * AW ? r0 : r0 + 2 * SW;
        I.src = ((const float*)args.in[2]) + (size_t)k0 * INW + n0; I.dst = B_WIN8 + (size_t)r0 * D + k0; I.N = INW; I.K = D; I.scale = pg8::SC_WGU; }
}
__device__ __forceinline__ void p0_item8_load(const P0Item& I, int lane, f32x4 (&v)[4][4]) {
    const int c = lane & 7, r = lane >> 3;
    const float* p = I.src + (size_t)(4 * r) * I.N + 4 * c;
#pragma unroll
    for (int j = 0; j < 4; ++j)
#pragma unroll
        for (int i = 0; i < 4; ++i) v[j][i] = __builtin_nontemporal_load((const f32x4*)(p + (size_t)(32 * j + i) * I.N));
}
__device__ __forceinline__ void p0_item8_store(const P0Item& I, int lane, const f32x4 (&v)[4][4], LAS unsigned* scr) {
    const int c = lane & 7, r = lane >> 3; const float s = I.scale;
#pragma unroll
    for (int j = 0; j < 4; ++j)
#pragma unroll
        for (int m = 0; m < 4; ++m) scr[(4 * c + m) * 33 + r + 8 * j] = pg8::pk4_fp8(v[j][0][m] * s, v[j][1][m] * s, v[j][2][m] * s, v[j][3][m] * s);
    asm volatile("s_waitcnt lgkmcnt(0)" ::: "memory");
    const int ch = lane & 7;
#pragma unroll
    for (int jj = 0; jj < 4; ++jj) { const int n = (lane >> 3) + 8 * jj; const LAS unsigned* q = scr + n * 33 + 4 * ch;
        u32x4 o; o.x = q[0]; o.y = q[1]; o.z = q[2]; o.w = q[3];
        *(u32x4*)(I.dst + (size_t)n * I.K + 16 * ch) = o; }
    asm volatile("s_waitcnt lgkmcnt(0)" ::: "memory");
}
#ifndef BG_NB
#define BG_NB 128
#endif
#ifndef BG_F0
#define BG_F0 0
#endif
constexpr int BG_N0 = (int)((long)N8E * BG_F0 / 1000);
__device__ __forceinline__ void p0_items8(const Args& args, Frame& F, int lo, int hi, int gw, int NGW) {
    LAS unsigned* scr8 = (LAS unsigned*)(F.lds + F.wave * 16384);
    f32x4 va[4][4], vb[4][4], vc[4][4]; P0Item Ia, Ib, Ic;
    int it = lo + gw;
    if (it < hi) { p0_item8_decode(args, F, it, Ia); p0_item8_load(Ia, F.lane, va); }
    if (it + NGW < hi) { p0_item8_decode(args, F, it + NGW, Ib); p0_item8_load(Ib, F.lane, vb); }
    while (it < hi) {
        if (it + 2 * NGW < hi) { p0_item8_decode(args, F, it + 2 * NGW, Ic); p0_item8_load(Ic, F.lane, vc); }
        p0_item8_store(Ia, F.lane, va, scr8);
        it += NGW; if (it >= hi) break;
        if (it + 2 * NGW < hi) { p0_item8_decode(args, F, it + 2 * NGW, Ia); p0_item8_load(Ia, F.lane, va); }
        p0_item8_store(Ib, F.lane, vb, scr8);
        it += NGW; if (it >= hi) break;
        if (it + 2 * NGW < hi) { p0_item8_decode(args, F, it + 2 * NGW, Ib); p0_item8_load(Ib, F.lane, vb); }
        p0_item8_store(Ic, F.lane, vc, scr8);
        it += NGW;
    }
}
__device__ __forceinline__ void p0_convert(const Args& args, Frame& F) {
    LAS float* scr = (LAS float*)(F.lds + F.wave * 16384);
    const int gw = F.bx * 8 + F.wave, NGW = F.G * 8;
    constexpr int I_IN = (D / 64) * (2 * SW / 32), I_A = (AO / 64) * (D / 32), I_B = (SW / 64) * (D / 32);
    constexpr int NITEMS = I_IN + I_A + I_B;
    for (int it = gw; it < NITEMS; it += NGW) {
        int r = it;
        if (r < I_IN) { const int nb = 2 * SW / 32; p0_transpose_item(((const float*)args.in[2]), D, INW, B_WIN, 64 * (r / nb), 3 * AW + 32 * (r % nb), 32 * (r % nb), scr, F.lane); continue; } r -= I_IN;
        if (r < I_A) { const int nb = D / 32; p0_transpose_item(((const float*)args.in[3]), AO, D, B_WA, 64 * (r / nb), 32 * (r % nb), 32 * (r % nb), scr, F.lane); continue; } r -= I_A;
        { const int nb = D / 32; p0_transpose_item(((const float*)args.in[8]), SW, D, B_WB, 64 * (r / nb), 32 * (r % nb), 32 * (r % nb), scr, F.lane); }
    }
    p0_items8(args, F, 0, BG_N0, gw, NGW);
    p0_items8(args, F, N8E, N8, gw, NGW);
    const size_t gt = (size_t)F.bx * 512 + F.tid, NT = (size_t)F.G * 512;
    for (size_t i0 = gt; i0 < (size_t)S * D / 8; i0 += 4 * NT) {
        f32x4 a[4], b[4];
#pragma unroll
        for (int u = 0; u < 4; ++u) { const size_t i = i0 + u * NT; if (i < (size_t)S * D / 8) { a[u] = __builtin_nontemporal_load(((const f32x4*)((const float*)args.in[0])) + 2 * i); b[u] = __builtin_nontemporal_load(((const f32x4*)((const float*)args.in[0])) + 2 * i + 1); } }
#pragma unroll
        for (int u = 0; u < 4; ++u) { const size_t i = i0 + u * NT; if (i < (size_t)S * D / 8) {
            u32x4 w; w.x = cvt_pk_bf16(a[u][0], a[u][1]); w.y = cvt_pk_bf16(a[u][2], a[u][3]); w.z = cvt_pk_bf16(b[u][0], b[u][1]); w.w = cvt_pk_bf16(b[u][2], b[u][3]); ((u32x4*)B_XB)[i] = w;
            u32x2 w8; w8.x = pg8::pk4_fp8(pg8::clamp448(a[u][0] * pg8::SC_X1), pg8::clamp448(a[u][1] * pg8::SC_X1), pg8::clamp448(a[u][2] * pg8::SC_X1), pg8::clamp448(a[u][3] * pg8::SC_X1));
            w8.y = pg8::pk4_fp8(pg8::clamp448(b[u][0] * pg8::SC_X1), pg8::clamp448(b[u][1] * pg8::SC_X1), pg8::clamp448(b[u][2] * pg8::SC_X1), pg8::clamp448(b[u][3] * pg8::SC_X1)); ((u32x2*)B_X8)[i] = w8; } }
    }
    for (size_t i = gt; i < (size_t)MAXROWS; i += NT) B_ROWTOK[i] = 0;
    for (size_t i = gt; i < (size_t)8 * 128 * 128 / 8; i += NT) { const f32x4 a = ((const f32x4*)((const float*)args.in[6]))[2 * i], b = ((const f32x4*)((const float*)args.in[6]))[2 * i + 1];
        u32x4 w; w.x = cvt_pk_bf16(a[0], a[1]); w.y = cvt_pk_bf16(a[2], a[3]); w.z = cvt_pk_bf16(b[0], b[1]); w.w = cvt_pk_bf16(b[2], b[3]); ((u32x4*)B_SGW)[i] = w; }
    for (size_t i = gt; i < (size_t)NE * D; i += NT) { const int e = (int)(i >> 11), k = (int)(i & 2047);
        ((_Float16*)B_WRT)[i] = (_Float16)((const float*)args.in[12])[(size_t)k * NE + e]; }
    for (size_t i = gt; i < (size_t)S * 16; i += NT) { const int t = (int)(i >> 4), j = (int)(i & 15);
        const float invf = (float)exp2(-(double)j * (18.931568569324174 / 16.0));
        const float ang = (float)((const int*)args.in[1])[t] * invf; float sn, cn; sincosf(ang, &sn, &cn);
        B_CS[2 * i] = cn; B_CS[2 * i + 1] = sn; }
}

struct AttnGeom { int g, h, dsh, L, r, b, hcol, sj0; };
__device__ __forceinline__ void attn_geom(int unit, AttnGeom& A) {
    A.g = unit / 512; A.h = (unit >> 7) & 3; const int blk = unit & 127;
    A.dsh = 2 * A.g; A.L = S >> A.dsh; const int bpr = A.L >> 7;
    A.r = blk / bpr; A.b = blk % bpr; A.hcol = A.g * 512 + A.h * 128; A.sj0 = A.b * 128 - 64;
}
__device__ __forceinline__ void attn_dma(Frame& F, const bf16* base, LAS unsigned char* img, const AttnGeom& A) {
#pragma unroll
    for (int ii = 0; ii < 8; ++ii) {
        const int i = F.wave + 8 * ii, j = 4 * i + (F.lane >> 4), cp = F.lane & 15, ch = cp ^ (((j & 3) << 2) | ((j >> 2) & 3));
        int sj = A.sj0 + j; sj = sj < 0 ? 0 : (sj > A.L - 1 ? A.L - 1 : sj);
        const size_t tok = ((size_t)sj << A.dsh) + A.r;
        __builtin_amdgcn_global_load_lds((const unsigned*)(base + tok * AW + A.hcol + 8 * ch), (LAS unsigned*)(img + i * 1024), 16, 0, 0);
    }
}
__device__ __forceinline__ void attn_phase(Frame& F) {
    LAS unsigned char* Kimg = F.lds;
    LAS unsigned char* Vimg = F.lds + 65536;
    int unit = F.c; if (unit >= 1536) return;
    AttnGeom A; attn_geom(unit, A);
    attn_dma(F, B_KB, Kimg, A); attn_dma(F, B_VB, Vimg, A);
    for (;;) {
        const int un = unit + F.GG; const bool hn = un < 1536; AttnGeom An = A; if (hn) attn_geom(un, An);
        const int g = A.g, h = A.h, dsh = A.dsh, L = A.L, r = A.r, b = A.b, hcol = A.hcol, sj0 = A.sj0;
        const int jmin = sj0 < 0 ? -sj0 : 0, jmax = (L - sj0) < 256 ? (L - sj0) : 256;
        const int w = F.wave, lane = F.lane, fr = lane & 15, fq = lane >> 4;
        const int iq = 16 * w + fr;
        const size_t tq = ((size_t)(b * 128 + iq) << dsh) + r;
        bf16x8 Qf[4];
#pragma unroll
        for (int ks = 0; ks < 4; ++ks) Qf[ks] = *(const bf16x8*)(B_QB + tq * AW + hcol + 32 * ks + 8 * fq);
        asm volatile("s_waitcnt vmcnt(0)" ::: "memory"); __builtin_amdgcn_s_barrier(); asm volatile("" ::: "memory");
        const int sb0 = w >> 1;
        f32x4 Sx[5][2];
        const int krow = 8 * (fr >> 2) + (fr & 3);
        const LAS unsigned char* Kw = Kimg + sb0 * 8192;
        unsigned kaddr[2][4];
#pragma unroll
        for (int hf = 0; hf < 2; ++hf)
#pragma unroll
            for (int ks = 0; ks < 4; ++ks) kaddr[hf][ks] = off_b(krow + 4 * hf, 4 * ks + fq);
#pragma unroll
        for (int sbi = 0; sbi < 5; ++sbi)
#pragma unroll
            for (int hf = 0; hf < 2; ++hf) {
                f32x4 a = (f32x4){0.f, 0.f, 0.f, 0.f};
#pragma unroll
                for (int ks = 0; ks < 4; ++ks) {
                    const bf16x8 kf = *(const LAS bf16x8*)(Kw + kaddr[hf][ks] + sbi * 8192);
                    a = __builtin_amdgcn_mfma_f32_16x16x32_bf16(kf, Qf[ks], a, 0, 0, 0);
                }
                Sx[sbi][hf] = a;
            }
        asm volatile("s_waitcnt lgkmcnt(0)" ::: "memory"); __builtin_amdgcn_s_barrier(); asm volatile("" ::: "memory");
        if (hn) attn_dma(F, B_KB, Kimg, An);
        const float sc = 0.08838834764831845f;
        float mx = -3.0e38f;
#pragma unroll
        for (int sbi = 0; sbi < 5; ++sbi)
#pragma unroll
            for (int hf = 0; hf < 2; ++hf)
#pragma unroll
                for (int j = 0; j < 4; ++j) {
                    const int kj = 32 * (sb0 + sbi) + 8 * fq + 4 * hf + j;
                    const bool ok = (kj >= iq) && (kj <= iq + 128) && (kj >= jmin) && (kj < jmax);
                    const float s = ok ? Sx[sbi][hf][j] * sc : -1.0e30f;
                    Sx[sbi][hf][j] = s; mx = fmaxf(mx, s);
                }
        mx = fmaxf(mx, __shfl_xor(mx, 16)); mx = fmaxf(mx, __shfl_xor(mx, 32));
        float den = 0.f;
#pragma unroll
        for (int sbi = 0; sbi < 5; ++sbi)
#pragma unroll
            for (int hf = 0; hf < 2; ++hf)
#pragma unroll
                for (int j = 0; j < 4; ++j) { const float p = fast_exp2((Sx[sbi][hf][j] - mx) * 1.44269504089f); Sx[sbi][hf][j] = p; den += p; }
        den += __shfl_xor(den, 16); den += __shfl_xor(den, 32);
        bf16x8 Pf[5];
#pragma unroll
        for (int sbi = 0; sbi < 5; ++sbi) {
            u32x4 w4; w4.x = cvt_pk_bf16(Sx[sbi][0][0], Sx[sbi][0][1]); w4.y = cvt_pk_bf16(Sx[sbi][0][2], Sx[sbi][0][3]);
            w4.z = cvt_pk_bf16(Sx[sbi][1][0], Sx[sbi][1][1]); w4.w = cvt_pk_bf16(Sx[sbi][1][2], Sx[sbi][1][3]);
            Pf[sbi] = __builtin_bit_cast(bf16x8, w4);
        }
        f32x4 O[8];
#pragma unroll
        for (int c = 0; c < 8; ++c) O[c] = (f32x4){0.f, 0.f, 0.f, 0.f};
        const unsigned vbase = (unsigned)(size_t)Vimg + (unsigned)sb0 * 8192u;
        unsigned vaddr[8][2];
#pragma unroll
        for (int c = 0; c < 8; ++c) { vaddr[c][0] = vbase + tr_addr16(lane, c, 0, 0); vaddr[c][1] = vbase + tr_addr16(lane, c, 0, 1); }
#define PV_STEP(sbi) do { bf16x8 vf[8]; tr_read16<(sbi) * 8192>(vaddr, vf); _Pragma("unroll") for (int c = 0; c < 8; ++c) \
            O[c] = __builtin_amdgcn_mfma_f32_16x16x32_bf16(vf[c], Pf[sbi], O[c], 0, 0, 0); } while (0)
        PV_STEP(0); PV_STEP(1); PV_STEP(2); PV_STEP(3); PV_STEP(4);
#undef PV_STEP
        const float rden = 1.0f / den;
        bf16* op = B_OG + ((size_t)g * S + tq) * AO + h * 128 + 4 * fq;
#pragma unroll
        for (int c = 0; c < 8; ++c) { const f32x4 o = O[c] * rden; u32x2 w2; w2.x = cvt_pk_bf16(o[0], o[1]); w2.y = cvt_pk_bf16(o[2], o[3]); *(u32x2*)(op + 16 * c) = w2; }
        asm volatile("s_waitcnt lgkmcnt(0)" ::: "memory"); __builtin_amdgcn_s_barrier(); asm volatile("" ::: "memory");
        if (hn) attn_dma(F, B_VB, Vimg, An);
        if (fq == 0) B_LSE[((size_t)g * S + tq) * 4 + h] = mx + __logf(den);
        if (!hn) break;
        unit = un; A = An;
    }
    asm volatile("s_waitcnt vmcnt(0)" ::: "memory"); __syncthreads();
}
__device__ __forceinline__ void sgu_stats(Frame& F) {
    const int gw = F.c * 8 + F.wave, NGW = F.GG * 8;
    for (int tb = gw; tb < S; tb += 4 * NGW) {
        u32x4 a[4], b[4];
#pragma unroll
        for (int i = 0; i < 4; ++i) { const int t = tb + i * NGW; const u32x4* p = (const u32x4*)(B_ZB + (size_t)(t < S ? t : 0) * 2048 + SW + 16 * F.lane); a[i] = p[0]; b[i] = p[1]; }
#pragma unroll
        for (int i = 0; i < 4; ++i) {
            const int t = tb + i * NGW;
            float v[16] = {bflo(a[i].x), bfhi(a[i].x), bflo(a[i].y), bfhi(a[i].y), bflo(a[i].z), bfhi(a[i].z), bflo(a[i].w), bfhi(a[i].w), bflo(b[i].x), bfhi(b[i].x), bflo(b[i].y), bfhi(b[i].y), bflo(b[i].z), bfhi(b[i].z), bflo(b[i].w), bfhi(b[i].w)};
            float s = 0.f;
#pragma unroll
            for (int k = 0; k < 16; ++k) s += v[k];
            const float mean = wave_sum(s) * (1.0f / SW);
            float q = 0.f;
#pragma unroll
            for (int k = 0; k < 16; ++k) { const float d = v[k] - mean; q += d * d; }
            const float rstd = 1.0f / sqrtf(wave_sum(q) * (1.0f / SW) + LN_EPS);
            if (F.lane == 0 && t < S) { B_VST[2 * t] = mean; B_VST[2 * t + 1] = rstd; }
        }
    }
}
__device__ __forceinline__ void sgu_unit(const Args& args, Frame& F, int unit) {
    const int c = unit >> 3, g = unit & 7, t0 = 128 * c;
    const int w = F.wave, lane = F.lane, fr = lane & 15, fq = lane >> 4;
    LAS unsigned char* Vimg = F.lds;
#pragma unroll
    for (int i = 0; i < 4; ++i) {
        const int q = F.tid + 512 * i, s = q >> 4, ch = q & 15;
        const u32x4 a = *(const u32x4*)(B_ZB + (size_t)(t0 + s) * 2048 + SW + 128 * g + 8 * ch);
        const f32x2 ms = *(const f32x2*)(B_VST + 2 * (t0 + s)); const float mean = ms.x, rstd = ms.y;
        const float* gp = ((const float*)args.in[4]) + 128 * g + 8 * ch; const float* bp = ((const float*)args.in[5]) + 128 * g + 8 * ch;
        const f32x4 g0 = *(const f32x4*)gp, g1 = *(const f32x4*)(gp + 4), b0 = *(const f32x4*)bp, b1 = *(const f32x4*)(bp + 4);
        float v[8] = {bflo(a.x), bfhi(a.x), bflo(a.y), bfhi(a.y), bflo(a.z), bfhi(a.z), bflo(a.w), bfhi(a.w)};
#pragma unroll
        for (int e = 0; e < 8; ++e) v[e] = (v[e] - mean) * rstd * (e < 4 ? g0[e & 3] : g1[e & 3]) + (e < 4 ? b0[e & 3] : b1[e & 3]);
        u32x4 o; o.x = cvt_pk_bf16(v[0], v[1]); o.y = cvt_pk_bf16(v[2], v[3]); o.z = cvt_pk_bf16(v[4], v[5]); o.w = cvt_pk_bf16(v[6], v[7]);
        *(LAS u32x4*)(Vimg + off_b(s, ch)) = o;
    }
    bf16x8 Wf[4];
#pragma unroll
    for (int ks = 0; ks < 4; ++ks) Wf[ks] = *(const bf16x8*)(B_SGW + ((size_t)(g * 128 + 16 * w + fr)) * 128 + 32 * ks + 8 * fq);
    __syncthreads();
    const unsigned vbase = (unsigned)(size_t)Vimg;
    const int t = t0 + 16 * w + fr;
    const float bias = ((const float*)args.in[7])[g * 128 + 16 * w + fr];
#pragma unroll
    for (int cb = 0; cb < 8; ++cb) {
        f32x4 a = (f32x4){0.f, 0.f, 0.f, 0.f};
        const unsigned a0 = vbase + tr_addr16(lane, cb, 0, 0), a1 = vbase + tr_addr16(lane, cb, 0, 1);
        a = __builtin_amdgcn_mfma_f32_16x16x32_bf16(tr_read2<0>(a0, a1), Wf[0], a, 0, 0, 0);
        a = __builtin_amdgcn_mfma_f32_16x16x32_bf16(tr_read2<8192>(a0, a1), Wf[1], a, 0, 0, 0);
        a = __builtin_amdgcn_mfma_f32_16x16x32_bf16(tr_read2<16384>(a0, a1), Wf[2], a, 0, 0, 0);
        a = __builtin_amdgcn_mfma_f32_16x16x32_bf16(tr_read2<24576>(a0, a1), Wf[3], a, 0, 0, 0);
        const int chn = 128 * g + 16 * cb + 4 * fq;
        const u32x2 uu = *(const u32x2*)(B_ZB + (size_t)t * 2048 + chn);
        u32x2 o; o.x = cvt_pk_bf16(bflo(uu.x) * (a[0] + bias), bfhi(uu.x) * (a[1] + bias)); o.y = cvt_pk_bf16(bflo(uu.y) * (a[2] + bias), bfhi(uu.y) * (a[3] + bias));
        *(u32x2*)(B_SGI + (size_t)t * SW + chn) = o;
    }
    __syncthreads();
}

__device__ __forceinline__ void p3_combine(Frame& F) {
    const size_t gt = (size_t)F.c * 512 + F.tid, NT = (size_t)F.GG * 512;
    for (size_t i = gt; i < (size_t)S * AO / 8; i += NT) {
        const int t = (int)(i >> 6), c8 = (int)(i & 63), h = c8 >> 4;
        const float l0 = B_LSE[((size_t)0 * S + t) * 4 + h], l1 = B_LSE[((size_t)1 * S + t) * 4 + h], l2 = B_LSE[((size_t)2 * S + t) * 4 + h];
        const float m = fmaxf(l0, fmaxf(l1, l2));
        float w0 = __expf(l0 - m), w1 = __expf(l1 - m), w2 = __expf(l2 - m); const float rs = 1.0f / (w0 + w1 + w2); w0 *= rs; w1 *= rs; w2 *= rs;
        const u32x4 q0 = *(const u32x4*)(B_OG + ((size_t)0 * S + t) * AO + 8 * c8), q1 = *(const u32x4*)(B_OG + ((size_t)1 * S + t) * AO + 8 * c8), q2 = *(const u32x4*)(B_OG + ((size_t)2 * S + t) * AO + 8 * c8);
        const f32x4 a = (f32x4){bflo(q0.x), bfhi(q0.x), bflo(q0.y), bfhi(q0.y)} * w0 + (f32x4){bflo(q1.x), bfhi(q1.x), bflo(q1.y), bfhi(q1.y)} * w1 + (f32x4){bflo(q2.x), bfhi(q2.x), bflo(q2.y), bfhi(q2.y)} * w2;
        const f32x4 b = (f32x4){bflo(q0.z), bfhi(q0.z), bflo(q0.w), bfhi(q0.w)} * w0 + (f32x4){bflo(q1.z), bfhi(q1.z), bflo(q1.w), bfhi(q1.w)} * w1 + (f32x4){bflo(q2.z), bfhi(q2.z), bflo(q2.w), bfhi(q2.w)} * w2;
        u32x4 o; o.x = cvt_pk_bf16(a[0], a[1]); o.y = cvt_pk_bf16(a[2], a[3]); o.z = cvt_pk_bf16(b[0], b[1]); o.w = cvt_pk_bf16(b[2], b[3]);
        ((u32x4*)B_OA)[i] = o;
    }
}

__device__ __forceinline__ void p6_ln_router(const Args& args, Frame& F) {
    LAS float* xl = (LAS float*)F.lds;
    LAS float* part = (LAS float*)(F.lds + LDS_PART);
    LAS float* lg = (LAS float*)(F.lds + LDS_MISC + MISC_LG);
    LAS float* sel = lg + 512;
    LAS int* lcnt = (LAS int*)(F.lds + LDS_MISC + MISC_LC);
    const int fr = F.lane & 15, fq = F.lane >> 4;
    if (F.tid < 32) lcnt[F.tid] = 0;
    __syncthreads();
    h16x8 Bw[8][2];
    {   const _Float16* wh = (const _Float16*)B_WRT + (size_t)fr * D + 256 * F.wave + 8 * fq;
#pragma unroll
        for (int ks = 0; ks < 8; ++ks)
#pragma unroll
            for (int nb = 0; nb < 2; ++nb) Bw[ks][nb] = *(const h16x8*)(wh + (size_t)(16 * nb) * D + 32 * ks); }
    const float brt = ((const float*)args.in[13])[F.tid & 31];
    u32x4 raw[2][4];
    int it = F.c;
    if (it < S / 16) {
#pragma unroll
        for (int rr = 0; rr < 2; ++rr) { const u32x4* xp = (const u32x4*)(B_X1F + (size_t)(16 * it + 2 * F.wave + rr) * D) + F.lane;
#pragma unroll
            for (int j = 0; j < 4; ++j) raw[rr][j] = xp[64 * j]; }
    }
    for (; it < S / 16; it += F.GG) {
        const int t0 = 16 * it;
#pragma unroll
        for (int rr = 0; rr < 2; ++rr) {
            const int rl = 2 * F.wave + rr; const size_t row = (size_t)(t0 + rl);
            f32x4 v[4][2];
#pragma unroll
            for (int j = 0; j < 4; ++j) { const u32x4 r4 = raw[rr][j]; v[j][0] = (f32x4){bflo(r4.x), bfhi(r4.x), bflo(r4.y), bfhi(r4.y)}; v[j][1] = (f32x4){bflo(r4.z), bfhi(r4.z), bflo(r4.w), bfhi(r4.w)}; }
            float s = 0.f;
#pragma unroll
            for (int j = 0; j < 4; ++j)
#pragma unroll
                for (int hh = 0; hh < 2; ++hh) s += (v[j][hh][0] + v[j][hh][1]) + (v[j][hh][2] + v[j][hh][3]);
            const float mean = wave_sum(s) * (1.0f / D); float q = 0.f;
#pragma unroll
            for (int j = 0; j < 4; ++j)
#pragma unroll
                for (int hh = 0; hh < 2; ++hh) { v[j][hh] = v[j][hh] - mean; q += (v[j][hh][0] * v[j][hh][0] + v[j][hh][1] * v[j][hh][1]) + (v[j][hh][2] * v[j][hh][2] + v[j][hh][3] * v[j][hh][3]); }
            const float rstd = 1.0f / sqrtf(wave_sum(q) * (1.0f / D) + LN_EPS);
            if (F.lane == 0) *(f32x2*)(B_LN1ST + 2 * row) = (f32x2){mean, rstd};
#pragma unroll
            for (int j = 0; j < 4; ++j) {
                const int col = 8 * F.lane + 512 * j;
                const float* gp = ((const float*)args.in[10]) + col; const float* bp = ((const float*)args.in[11]) + col;
                const f32x4 y0 = v[j][0] * rstd * *(const f32x4*)gp + *(const f32x4*)bp, y1 = v[j][1] * rstd * *(const f32x4*)(gp + 4) + *(const f32x4*)(bp + 4);
                { u32x2 x8; x8.x = pg8::pk4_fp8(pg8::clamp448(y0[0] * pg8::SC_X1), pg8::clamp448(y0[1] * pg8::SC_X1), pg8::clamp448(y0[2] * pg8::SC_X1), pg8::clamp448(y0[3] * pg8::SC_X1));
                  x8.y = pg8::pk4_fp8(pg8::clamp448(y1[0] * pg8::SC_X1), pg8::clamp448(y1[1] * pg8::SC_X1), pg8::clamp448(y1[2] * pg8::SC_X1), pg8::clamp448(y1[3] * pg8::SC_X1));
                  *(u32x2*)(B_X1Q + row * D + col) = x8; }
                *(LAS f32x4*)(xl + rl * XLP + col) = y0; *(LAS f32x4*)(xl + rl * XLP + col + 4) = y1;
            }
        }
        __syncthreads();
        {
            f32x4 acc[2] = {(f32x4){0.f, 0.f, 0.f, 0.f}, (f32x4){0.f, 0.f, 0.f, 0.f}};
            const LAS float* xr = xl + fr * XLP + 256 * F.wave + 8 * fq;
#pragma unroll
            for (int ks = 0; ks < 8; ++ks) {
                const f32x4 a0 = *(const LAS f32x4*)(xr + 32 * ks), a1 = *(const LAS f32x4*)(xr + 32 * ks + 4);
                u32x4 hw;
                hw.x = __builtin_bit_cast(unsigned, __builtin_amdgcn_cvt_pkrtz(a0[0], a0[1])); hw.y = __builtin_bit_cast(unsigned, __builtin_amdgcn_cvt_pkrtz(a0[2], a0[3]));
                hw.z = __builtin_bit_cast(unsigned, __builtin_amdgcn_cvt_pkrtz(a1[0], a1[1])); hw.w = __builtin_bit_cast(unsigned, __builtin_amdgcn_cvt_pkrtz(a1[2], a1[3]));
                const h16x8 Ah = __builtin_bit_cast(h16x8, hw);
#pragma unroll
                for (int nb = 0; nb < 2; ++nb) acc[nb] = __builtin_amdgcn_mfma_f32_16x16x32_f16(Ah, Bw[ks][nb], acc[nb], 0, 0, 0);
            }
#pragma unroll
            for (int nb = 0; nb < 2; ++nb)
#pragma unroll
                for (int j = 0; j < 4; ++j) part[(F.wave * 16 + 4 * fq + j) * 32 + 16 * nb + fr] = acc[nb][j];
        }
        {   const int itn = it + F.GG;
            if (itn < S / 16) {
#pragma unroll
                for (int rr = 0; rr < 2; ++rr) { const u32x4* xp = (const u32x4*)(B_X1F + (size_t)(16 * itn + 2 * F.wave + rr) * D) + F.lane;
#pragma unroll
                    for (int j = 0; j < 4; ++j) raw[rr][j] = xp[64 * j]; }
            } }
        __syncthreads();
        {
            const int tl = F.tid >> 5, e = F.tid & 31, t = t0 + tl; float lgt = brt;
#pragma unroll
            for (int w8 = 0; w8 < 8; ++w8) lgt += part[(w8 * 16 + tl) * 32 + e];
            lg[tl * 32 + e] = lgt;
            asm volatile("s_waitcnt lgkmcnt(0)" ::: "memory");
            int rank = 0;
#pragma unroll
            for (int q4 = 0; q4 < 8; ++q4) { const f32x4 o = *(const LAS f32x4*)(lg + tl * 32 + 4 * q4);
#pragma unroll
                for (int j = 0; j < 4; ++j) { const int e2 = 4 * q4 + j; rank += (o[j] > lgt || (o[j] == lgt && e2 < e)) ? 1 : 0; } }
            if (rank < 4) sel[tl * 4 + rank] = lgt;
            asm volatile("s_waitcnt lgkmcnt(0)" ::: "memory");
            if (rank < 4) {
                const f32x4 sv = *(const LAS f32x4*)(sel + tl * 4);
                const float den = 1.0f + __expf(sv[1] - sv[0]) + __expf(sv[2] - sv[0]) + __expf(sv[3] - sv[0]);
                const int lrank = __hip_atomic_fetch_add(lcnt + e, 1, __ATOMIC_RELAXED, __HIP_MEMORY_SCOPE_WORKGROUP);
                B_TGATE[t * 4 + rank] = __expf(lgt - sv[0]) / den;
                B_INV[t * 4 + rank] = (e << 16) | lrank;
            }
        }
        __syncthreads();
    }
    if (F.tid < 32) B_CNTWG[F.c * 32 + F.tid] = lcnt[F.tid];
}
__device__ __forceinline__ void compute_tp(Frame& F) {
    LAS int* tp = (LAS int*)(F.lds + LDS_MISC + MISC_TP); LAS int* cnt = (LAS int*)(F.lds + LDS_MISC + MISC_CNT); LAS int* base = (LAS int*)(F.lds + LDS_MISC + MISC_BASE);
    LAS int* part = (LAS int*)(F.lds + LDS_MISC + MISC_PART);
    {   const int e = F.tid & 31, p = F.tid >> 5, per = (F.GG + 15) >> 4; int tot = 0, pre = 0;
        for (int i = 0; i < per; ++i) { const int wg = p * per + i; if (wg < F.GG) { const int c = B_CNTWG[wg * 32 + e]; tot += c; pre += (wg < F.c) ? c : 0; } }
        part[p * 32 + e] = tot; part[512 + p * 32 + e] = pre; }
    __syncthreads();
    if (F.tid < 32) { int tot = 0, pre = 0;
#pragma unroll
        for (int p = 0; p < 16; ++p) { tot += part[p * 32 + F.tid]; pre += part[512 + p * 32 + F.tid]; }
        cnt[F.tid] = tot; base[F.tid] = pre; }
    __syncthreads();
    if (F.tid == 0) { int acc = 0; tp[0] = 0; for (int e = 0; e < NE; ++e) { acc += (cnt[e] + 255) >> 8; tp[e + 1] = acc; } }
    __syncthreads();
}
__device__ __forceinline__ void load_tp(Frame& F) {
    LAS int* tp = (LAS int*)(F.lds + LDS_MISC + MISC_TP); LAS int* cnt = (LAS int*)(F.lds + LDS_MISC + MISC_CNT);
    if (F.tid < 33) tp[F.tid] = B_TPG[F.tid];
    if (F.tid >= 64 && F.tid < 96) cnt[F.tid - 64] = B_TPG[33 + F.tid - 64];
    __syncthreads();
}
__device__ __forceinline__ void p7_scatter(Frame& F) {
    const LAS int* tp = (const LAS int*)(F.lds + LDS_MISC + MISC_TP); const LAS int* base = (const LAS int*)(F.lds + LDS_MISC + MISC_BASE);
    for (int q = F.tid; ; q += 512) {
        const int it = F.c + (q >> 6) * F.GG; if (it >= S / 16) break;
        const int i = (16 * it) * 4 + (q & 63), es = B_INV[i], e = es >> 16;
        const int R = 256 * tp[e] + base[e] + (es & 0xffff);
        B_ROWTOK[R] = i >> 2; B_RGATE[R] = B_TGATE[i]; B_INV[i] = R;
    }
}
__device__ __forceinline__ f32x4 fp8x4_to_f32(unsigned w) { const f32x2 lo = __builtin_amdgcn_cvt_pk_f32_fp8((int)w, false), hi = __builtin_amdgcn_cvt_pk_f32_fp8((int)w, true); return (f32x4){lo.x, lo.y, hi.x, hi.y}; }
__device__ __forceinline__ void p10_final(const Args& args, Frame& F) {
    const int gw = F.c * 8 + F.wave, NGW = F.GG * 8;
    int Rn[4] = {0, 0, 0, 0};
    u32x4 ya[2][4], xh[2][2]; f32x2 st1 = (f32x2){0.f, 1.f};
    LAS float* gl = (LAS float*)F.lds; LAS float* bl = gl + D; LAS float* g2l = bl + D; LAS float* b2l = g2l + D;
    for (int i = F.tid; i < D; i += 512) { gl[i] = ((const float*)args.in[10])[i]; bl[i] = ALPHA * ((const float*)args.in[11])[i]; g2l[i] = ((const float*)args.in[18])[i]; b2l[i] = ((const float*)args.in[19])[i]; }
    __syncthreads();
#define P10_ROWS(tt) do { _Pragma("unroll") for (int k = 0; k < 4; ++k) Rn[k] = B_INV[(tt) * 4 + k]; } while (0)
#define P10_LOAD(tt) do { const u32x4* xp_ = (const u32x4*)(B_X1F + (size_t)(tt) * D) + 2 * F.lane; st1 = *(const f32x2*)(B_LN1ST + 2 * (size_t)(tt)); \
        _Pragma("unroll") for (int j = 0; j < 2; ++j) { _Pragma("unroll") for (int k = 0; k < 4; ++k) ya[j][k] = *(const u32x4*)(B_YB + (size_t)Rn[k] * D + 16 * F.lane + 1024 * j); \
            xh[j][0] = xp_[128 * j]; xh[j][1] = xp_[128 * j + 1]; } } while (0)
    if (gw < S) { P10_ROWS(gw); P10_LOAD(gw); if (gw + NGW < S) P10_ROWS(gw + NGW); }
    for (int t = gw; t < S; t += NGW) {
        f32x4 v[8]; float s = 0.f;
        const float a1 = ALPHA * st1.y, c1 = -st1.x * a1;
        int lo16 = 16 * F.lane; asm volatile("" : "+v"(lo16));
#pragma unroll
        for (int j = 0; j < 2; ++j) {
            const LAS float* gq = gl + lo16 + 1024 * j; const LAS float* bq = bl + lo16 + 1024 * j;
            f32x4 ys[4];
#pragma unroll
            for (int w = 0; w < 4; ++w) ys[w] = (f32x4){0.f, 0.f, 0.f, 0.f};
#pragma unroll
            for (int k = 0; k < 4; ++k) { const u32x4 a = ya[j][k]; ys[0] += fp8x4_to_f32(a.x); ys[1] += fp8x4_to_f32(a.y); ys[2] += fp8x4_to_f32(a.z); ys[3] += fp8x4_to_f32(a.w); }
            const u32x4 x0 = xh[j][0], x1 = xh[j][1];
            const f32x4 xr[4] = {(f32x4){bflo(x0.x), bfhi(x0.x), bflo(x0.y), bfhi(x0.y)}, (f32x4){bflo(x0.z), bfhi(x0.z), bflo(x0.w), bfhi(x0.w)},
                                 (f32x4){bflo(x1.x), bfhi(x1.x), bflo(x1.y), bfhi(x1.y)}, (f32x4){bflo(x1.z), bfhi(x1.z), bflo(x1.w), bfhi(x1.w)}};
#pragma unroll
            for (int w = 0; w < 4; ++w) {
                const f32x4 vv = (xr[w] * a1 + c1) * *(const LAS f32x4*)(gq + 4 * w) + (*(const LAS f32x4*)(bq + 4 * w) + ys[w] * (1.0f / pg8::SC_Y));
                v[4 * j + w] = vv; s += (vv[0] + vv[1]) + (vv[2] + vv[3]); }
        }
        if (t + NGW < S) { P10_LOAD(t + NGW); if (t + 2 * NGW < S) P10_ROWS(t + 2 * NGW); }
        const float mean = wave_sum(s) * (1.0f / D); float q = 0.f;
#pragma unroll
        for (int j = 0; j < 8; ++j) { v[j] = v[j] - mean; q += (v[j][0] * v[j][0] + v[j][1] * v[j][1]) + (v[j][2] * v[j][2] + v[j][3] * v[j][3]); }
        const float rstd = 1.0f / sqrtf(wave_sum(q) * (1.0f / D) + LN_EPS);
        float* op = args.out + (size_t)t * D;
#pragma unroll
        for (int j = 0; j < 2; ++j)
#pragma unroll
            for (int w = 0; w < 4; ++w) { const int col = 16 * F.lane + 1024 * j + 4 * w, lc = lo16 + 1024 * j + 4 * w;
                *(f32x4*)(op + col) = v[4 * j + w] * rstd * *(const LAS f32x4*)(g2l + lc) + *(const LAS f32x4*)(b2l + lc); }
    }
#undef P10_ROWS
#undef P10_LOAD
}

constexpr int N_PHASES = 11;
__global__ void __launch_bounds__(512, 2) mk_fwd(Args args) {
    extern __shared__ __attribute__((aligned(16))) unsigned char lds_raw[];
    Frame F;
    F.lds = (LAS unsigned char*)lds_raw;
    const int tid0 = threadIdx.x;
    F.tid = tid0; F.lane = tid0 & 63; F.wave = __builtin_amdgcn_readfirstlane(tid0 >> 6); F.G = gridDim.x; F.bx = blockIdx.x; F.c = F.bx; F.GG = F.G;
    unsigned char* ws = args.ws;
    F.ws = ws; F.ctl = (unsigned*)(ws + WS_CTL);
    for (int u = tid0; u < (LDS_BYTES - LDS_MISC) / 4; u += 512) ((LAS unsigned*)(F.lds + LDS_MISC))[u] = 0u;
    __syncthreads();
    const int lo = args.ph_lo, hi = args.ph_hi;
    const bool one = (hi - lo) > 1;
    XcdBarrier bar; bar.bar = F.ctl + CW_BAR; bar.x = 0; bar.st = (volatile LAS unsigned*)(F.lds + LDS_MISC + MISC_BAR);
    if (one) bar = xcd_barrier_post(F.ctl + CW_BAR, (volatile LAS unsigned*)(F.lds + LDS_MISC + MISC_BAR), tid0 == 0);
#ifndef PH_MASK
#define PH_MASK 0x7ff
#endif
#define IN(k) (((PH_MASK >> (k)) & 1) && lo <= (k) && (k) < hi)
#define SEAM(k) do { if (IN(k) && IN((k) + 1)) xcd_barrier(bar, F.wave == 0 && hw_lane() == 0); } while (0)
#define RELANE() do { F.lane = hw_lane(); F.tid = F.wave * 64 + F.lane; } while (0)
    const LAS int* tp = (const LAS int*)(F.lds + LDS_MISC + MISC_TP);

    const int GF = F.G - BG_NB; const bool bgw = (BG_NB > 0) && (F.bx >= GF);
    const int bgi = (F.bx - GF) * 8 + F.wave, bgn = BG_NB * 8;
    if (IN(0)) { RELANE(); p0_convert(args, F); }
    SEAM(0);
    if (IN(1)) { RELANE();
        if (bgw) { p0_items8(args, F, BG_N0, N8E, bgi, bgn); __syncthreads(); }
        { pg8::QueueOrder So; So.init(B_X8, B_WIN8, S, 3 * AW + 2 * D, D, F.ctl + CW_Q1, (volatile LAS unsigned*)(F.lds + LDS_MISC + MISC_QS), (int)xb_xcc_id(), F.wave);
          pg8::EpiIn E{B_QB, B_KB, B_VB, B_ZB, B_GT, B_CS, 0, 1.0f / (pg8::SC_X1 * pg8::SC_WGU)};
          pg8::gemm_phase<pg8::EpiIn, pg8::QueueOrder, true>(F.lds, D, So, E, F.wave); }
        { pg8::DenseOrder So; So.init(B_XB, B_WIN, S, 2 * SW, 2 * D, F.G, F.G - 1 - F.bx);
          pg8::EpiIn E{B_QB, B_KB, B_VB, B_ZB, B_GT, B_CS, 18, 1.0f};
          pg8::gemm_phase<pg8::EpiIn, pg8::DenseOrder>(F.lds, 2 * D, So, E, F.wave); }
    }
    SEAM(1);
    if (IN(2)) { RELANE(); attn_phase(F); sgu_stats(F); }
    SEAM(2);
    if (IN(3)) { RELANE(); for (int u = F.c; u < 1024; u += F.GG) sgu_unit(args, F, u); p3_combine(F); }
    SEAM(3);
    if (IN(4)) { RELANE();
        { pg8::DenseOrder So; So.init(B_OA, B_WA, S, D, 2 * AO, F.G, F.bx); pg8::EpiGateT<false> E{B_MRG, B_GT, 0, 0, nullptr};
          pg8::gemm_phase<pg8::EpiGateT<false>, pg8::DenseOrder>(F.lds, 2 * AO, So, E, F.wave); }
        { pg8::DenseOrder So; So.init(B_SGI, B_WB, S, D, 2 * SW, F.G, F.bx); pg8::EpiGateT<true> E{B_MRG, B_GT, 2048, 1, B_MRG8};
          pg8::gemm_phase<pg8::EpiGateT<true>, pg8::DenseOrder>(F.lds, 2 * SW, So, E, F.wave); }
    }
    SEAM(4);
    if (IN(5)) { RELANE(); pg8::DenseOrder So; So.init(B_MRG8, B_WO8, S, D, D, F.G, F.bx); pg8::EpiX1 E{B_XB, B_X1F, 1.0f / (pg8::SC_MRG * pg8::SC_WO)};
        pg8::gemm_phase<pg8::EpiX1, pg8::DenseOrder, true>(F.lds, D, So, E, F.wave); }
    SEAM(5);
    if (IN(6)) { RELANE(); p6_ln_router(args, F); }
    SEAM(6);
    if (IN(7)) { RELANE(); compute_tp(F); if (F.bx == 0) { if (F.tid < 33) B_TPG[F.tid] = tp[F.tid]; if (F.tid >= 64 && F.tid < 96) B_TPG[33 + F.tid - 64] = ((const LAS int*)(F.lds + LDS_MISC + MISC_CNT))[F.tid - 64]; } p7_scatter(F); }
    SEAM(7);
    if (IN(8)) { RELANE(); load_tp(F); pg8::MoeOrder So; So.init(B_X1Q, B_WGU8, tp, __builtin_amdgcn_readfirstlane(tp[32]), 2 * DE, D, F.G, F.bx); pg8::EpiSwiglu8 E{B_HB8, ((const float*)args.in[15])};
        So.rowtok = B_ROWTOK; So.ids = (LAS unsigned*)(F.lds + LDS_MISC + MISC_PART);
        pg8::gemm_phase<pg8::EpiSwiglu8, pg8::MoeOrder, true, true, true>(F.lds, D, So, E, F.wave); }
    SEAM(8);
    if (IN(9)) { RELANE(); load_tp(F);
        const int ntl = __builtin_amdgcn_readfirstlane(tp[32]), nun = ntl * (D / pg8::BM), lfull = (nun / F.G) * F.G, rem = nun - lfull;
        const bool split = rem > 0 && 2 * rem <= F.G;
        pg8::EpiDown E{B_YB, ((const float*)args.in[17]), B_RGATE, 1.0f / (pg8::SC_H * pg8::SC_WD), (LAS float*)(F.lds + LDS_MISC + MISC_PART)};
        { pg8::MoeOrder So; So.init(B_HB8, B_WD8, tp, ntl, D, DE, F.G, F.bx); So.lim = split ? lfull : nun;
          pg8::gemm_phase<pg8::EpiDown, pg8::MoeOrder, true>(F.lds, DE, So, E, F.wave); }
        if (split) { pg8::MoeHalfOrder Sh; Sh.init(B_HB8, B_WD8, tp, ntl, D, DE, F.bx, lfull, rem);
          pg8::gemm_phase<pg8::EpiDown, pg8::MoeHalfOrder, true, true, false, true>(F.lds, DE, Sh, E, F.wave); }
    }
    SEAM(9);
    if (IN(10)) { RELANE(); p10_final(args, F); }
#undef IN
#undef SEAM
#undef RELANE
}

extern "C" void kernel_launch(void* const* d_in, const int* in_sizes, int n_in, void* d_out, int out_size, void* d_ws, size_t ws_size, hipStream_t stream) {
    static int grid = 0;
    if (grid == 0) {
        if (n_in != 20 || in_sizes[0] != S * D || out_size != S * D || ws_size < WS_END) {
            fprintf(stderr, "kernel_launch: unexpected shapes/workspace (n_in %d, in0 %d, out %d, ws %zu, need %zu); nothing launched\n", n_in, n_in > 0 ? in_sizes[0] : -1, out_size, ws_size, (size_t)WS_END); grid = -1; return; }
        int dev = 0, cus = 0, per_cu = 0;
        if (hipGetDevice(&dev) != hipSuccess || hipDeviceGetAttribute(&cus, hipDeviceAttributeMultiprocessorCount, dev) != hipSuccess) { grid = -1; return; }
        if (hipFuncSetAttribute((const void*)mk_fwd, hipFuncAttributeMaxDynamicSharedMemorySize, LDS_BYTES) != hipSuccess) { fprintf(stderr, "kernel_launch: hipFuncSetAttribute failed\n"); grid = -1; return; }
        if (hipOccupancyMaxActiveBlocksPerMultiprocessor(&per_cu, (const void*)mk_fwd, 512, LDS_BYTES) != hipSuccess || per_cu < 1)
            fprintf(stderr, "kernel_launch: note: occupancy query reports %d workgroups per CU\n", per_cu);
        (void)hipGetLastError();
        grid = cus;
    }
    if (grid < 0) return;
    if (hipMemsetAsync((char*)d_ws + WS_CTL, 0, CTL_ZERO_BYTES, stream) != hipSuccess) { fprintf(stderr, "kernel_launch: memset failed\n"); return; }
    Args a{};
    for (int i = 0; i < 20; ++i) a.in[i] = d_in[i];
    a.out = (float*)d_out; a.ws = (unsigned char*)d_ws;
    a.ph_lo = 0; a.ph_hi = N_PHASES;
    hipLaunchKernelGGL(mk_fwd, dim3(grid), dim3(512), LDS_BYTES, stream, a);
}
```

```cpp
#include <hip/hip_runtime.h>
#include <cstdio>
#include <cstdint>

#define LAS __attribute__((address_space(3)))
#define GAS __attribute__((address_space(1)))
typedef unsigned short bf16;
typedef short bf16x8 __attribute__((ext_vector_type(8)));
typedef short s16x4 __attribute__((ext_vector_type(4)));
typedef float f32x4 __attribute__((ext_vector_type(4)));
typedef float f32x2 __attribute__((ext_vector_type(2)));
typedef unsigned u32x4 __attribute__((ext_vector_type(4)));
typedef unsigned u32x2 __attribute__((ext_vector_type(2)));
typedef _Float16 h16x8 __attribute__((ext_vector_type(8)));

constexpr int S = 16384, D = 2048, INW = 10752, AW = 1536, AO = 512, SW = 1024, NE = 32, TOPK = 4, DE = 2048;
constexpr int MAXROWS = 73728;
constexpr float LN_EPS = 1e-5f;
constexpr float ALPHA = 1.18920711500272106672f;

constexpr size_t MiB = 1u << 20;
constexpr size_t WS_CTL = 0, CTL_ZERO_BYTES = 64 * 1024;
constexpr size_t WS_XB = 1 * MiB;
constexpr size_t WS_WIN = WS_XB + 64 * MiB;
constexpr size_t WS_WA = WS_WIN + 42 * MiB;
constexpr size_t WS_WB = WS_WA + 2 * MiB;
constexpr size_t WS_WO = WS_WB + 4 * MiB;
constexpr size_t WS_WGU = WS_WO + 8 * MiB;
constexpr size_t WS_WD = WS_WGU + 512 * MiB;
constexpr size_t WS_SGW = WS_WD + 256 * MiB;
constexpr size_t WS_WRT = WS_SGW + 512 * 1024;
constexpr size_t WS_VST = WS_SGW + 768 * 1024;
constexpr size_t WS_CS = WS_SGW + 1 * MiB;
constexpr size_t WS_QB = WS_CS + 2 * MiB;
constexpr size_t WS_KB = WS_QB + 48 * MiB;
constexpr size_t WS_VB = WS_KB + 48 * MiB;
constexpr size_t WS_ZB = WS_VB + 48 * MiB;
constexpr size_t WS_GT = WS_ZB + 64 * MiB;
constexpr size_t WS_OG = WS_GT + 128 * MiB;
constexpr size_t WS_LSE = WS_OG + 96 * MiB;
constexpr size_t WS_OA = WS_LSE + 1 * MiB;
constexpr size_t WS_SGI = WS_OA + 16 * MiB;
constexpr size_t WS_MRG = WS_SGI + 32 * MiB;
constexpr size_t WS_X1F = WS_MRG + 64 * MiB;
constexpr size_t WS_X1B = WS_X1F + 128 * MiB;
constexpr size_t WS_STOK = WS_X1B + 64 * MiB;
constexpr size_t WS_SGATE = WS_STOK + 2 * MiB;
constexpr size_t WS_INV = WS_SGATE + 2 * MiB;
constexpr size_t WS_RGATE = WS_INV + 1 * MiB;
constexpr size_t WS_XS = WS_RGATE + 1 * MiB;
constexpr size_t WS_HB = WS_XS + 288 * MiB;
constexpr size_t WS_YB = WS_HB + 288 * MiB;
constexpr size_t WS_X8 = WS_YB + 288 * MiB;
constexpr size_t WS_WIN8 = WS_X8 + 32 * MiB;
constexpr size_t WS_END = WS_WIN8 + 17 * MiB;
constexpr int CW_TMO = 0, CW_BAR = 4096, CW_Q1 = 8192;

constexpr int RING_BYTES = 131072;
constexpr int XLP = 2052;
constexpr int LDS_PART = 16 * XLP * 4 + 256;
constexpr int LDS_MISC = LDS_PART + 16384;
constexpr int MISC_BAR = 0;
constexpr int MISC_QS = 16;
constexpr int MISC_TP = 64;
constexpr int MISC_CNT = 256;
constexpr int MISC_BASE = 384;
constexpr int MISC_LC = 512;
constexpr int MISC_LG = 1024;
constexpr int MISC_PART = 4096;
constexpr int LDS_BYTES = LDS_MISC + 8192;
static_assert(LDS_PART >= RING_BYTES && LDS_BYTES <= 163840, "LDS map");

__device__ __forceinline__ unsigned cvt_pk_bf16(float lo, float hi) { unsigned r; asm volatile("v_cvt_pk_bf16_f32 %0, %1, %2" : "=v"(r) : "v"(lo), "v"(hi)); return r; }
__device__ __forceinline__ float bflo(unsigned w) { return __uint_as_float(w << 16); }
__device__ __forceinline__ float bfhi(unsigned w) { return __uint_as_float(w & 0xffff0000u); }
__device__ __forceinline__ float wave_sum(float v) {
#pragma unroll
    for (int o = 1; o < 64; o <<= 1) v += __shfl_xor(v, o);
    return v;
}
__device__ __forceinline__ float fast_exp2(float x) { return __builtin_amdgcn_exp2f(x); }
__device__ __forceinline__ float sigmoidf_(float x) { return __builtin_amdgcn_rcpf(1.0f + fast_exp2(-1.44269504089f * x)); }

__device__ __forceinline__ int hw_lane() { int l; asm volatile("v_mbcnt_lo_u32_b32 %0, -1, 0\n\tv_mbcnt_hi_u32_b32 %0, -1, %0" : "=v"(l)); return l; }

#define XB_TMO      128
#define XB_XCNT(j)  (256  + 64 * (j))
#define XB_XSUB(j)  (1280 + 64 * (j))
#define XB_XGEN(j)  (2304 + 64 * (j))
#define XB_TOP      3328
#define XB_TOPGEN   3392
#define XCD_BAR_WORDS 3456
#define XB_SPIN_CAP (1u << 18)
__device__ __forceinline__ unsigned xb_ld(unsigned* p)              { return __hip_atomic_load(p, __ATOMIC_RELAXED, __HIP_MEMORY_SCOPE_AGENT); }
__device__ __forceinline__ unsigned xb_add(unsigned* p, unsigned v) { return __hip_atomic_fetch_add(p, v, __ATOMIC_RELAXED, __HIP_MEMORY_SCOPE_AGENT); }
__device__ __forceinline__ unsigned xb_xcc_id() { return (unsigned)__builtin_amdgcn_s_getreg((3 << 11) | 20) & 0xFu; }
#define XB_SPIN(cond, bar) do { unsigned _sp = 0; while (cond) { __builtin_amdgcn_s_sleep(1); \
    if ((++_sp & 255u) == 0u) { if (xb_ld(&(bar)[XB_TMO])) break; if (_sp > XB_SPIN_CAP) { atomicAdd(&(bar)[XB_TMO], 1u); break; } } } } while (0)
struct XcdBarrier { unsigned* bar; unsigned x; volatile LAS unsigned* st; };
__device__ __forceinline__ XcdBarrier xcd_barrier_post(unsigned* bar, volatile LAS unsigned* st, bool t0) {
    XcdBarrier b; b.bar = bar; b.x = xb_xcc_id(); b.st = st;
    if (t0) (void)xb_add(&bar[XB_XCNT(b.x)], 1u);
    return b;
}
__device__ __forceinline__ void xcd_barrier_complete(unsigned* bar, unsigned x, unsigned& nloc, unsigned& nx) {
    const unsigned G = gridDim.x * gridDim.y * gridDim.z;
    unsigned sum, cnt, mine, sp = 0u;
    for (;;) {
        sum = 0u; cnt = 0u; mine = 0u;
#pragma unroll
        for (unsigned j = 0; j < 16; ++j) { const unsigned c = xb_ld(&bar[XB_XCNT(j)]); sum += c; cnt += (c > 0u) ? 1u : 0u; mine = (j == x) ? c : mine; }
        if (sum == G) break;
        __builtin_amdgcn_s_sleep(1);
        if ((++sp & 255u) == 0u) { if (xb_ld(&bar[XB_TMO])) break; if (sp > XB_SPIN_CAP) { atomicAdd(&bar[XB_TMO], 1u); break; } }
    }
    nloc = mine > 0u ? mine : 1u; nx = cnt > 0u ? cnt : 1u;
}
__device__ __forceinline__ void xcd_barrier(const XcdBarrier& b, bool t0) {
    asm volatile("s_waitcnt vmcnt(0)" ::: "memory");
    __syncthreads();
    if (t0) {
        unsigned* bar = b.bar;
        __builtin_amdgcn_s_waitcnt(0);
        unsigned nloc = b.st[0], nx = b.st[1];
        if (nloc == 0u) { xcd_barrier_complete(bar, b.x, nloc, nx); b.st[0] = nloc; b.st[1] = nx; }
        const unsigned old = xb_add(&bar[XB_XSUB(b.x)], 1u);
        const unsigned gen = old / nloc;
        if (old + 1u == (gen + 1u) * nloc) {
            __builtin_amdgcn_fence(__ATOMIC_RELEASE, "agent");
            asm volatile("s_waitcnt vmcnt(0)" ::: "memory");
            const unsigned og = xb_add(&bar[XB_TOP], 1u);
            const unsigned tg = og / nx;
            if (og + 1u == (tg + 1u) * nx) xb_add(&bar[XB_TOPGEN], 1u);
            else XB_SPIN(xb_ld(&bar[XB_TOPGEN]) == tg, bar);
            __builtin_amdgcn_fence(__ATOMIC_ACQUIRE, "agent");
            asm volatile("s_waitcnt vmcnt(0)" ::: "memory");
        } else {
            XB_SPIN(xb_ld(&bar[XB_TOPGEN]) == gen, bar);
            __builtin_amdgcn_fence(__ATOMIC_ACQUIRE, "agent");
            asm volatile("s_waitcnt vmcnt(0)" ::: "memory");
        }
    }
    __syncthreads();
}

namespace pg8 {
constexpr int BM = 256, BK = 64, HALF = 128, HTB = HALF * BK * 2, STAGE_BYTES = 8 * HTB, NXCD = 8;
#ifndef WGM_D
#define WGM_D 4
#endif
#ifndef WGM_M
#define WGM_M 8
#endif
#ifndef WGM_QQ
#define WGM_QQ 4
#endif
constexpr int WGM = WGM_D, WGM_MOE = WGM_M, WGM_Q = WGM_QQ;
__host__ __device__ __forceinline__ int lds_byte(int r, int c) { const int st = (r >> 4) * 2 + (c >> 5), rr = r & 15, cc = c & 31, ob = rr * 64 + cc * 2; return st * 1024 + (ob ^ (((ob >> 9) & 1) << 5)); }
__host__ __device__ __forceinline__ void stage_rc(int b, int& R, int& C) { const int st = b / 1024, sb = b % 1024, swz = sb ^ (((sb >> 9) & 1) << 5); R = (st >> 1) * 16 + swz / 64; C = (st & 1) * 32 + (swz % 64) / 2; }
__host__ __device__ __forceinline__ int perm32(int rho) { const int n = rho >> 4, i = rho & 15; return 8 * (i >> 2) + 4 * n + (i & 3); }

struct Unit { const char* a; const char* b; int pm, pn, e, pad; };

__device__ __forceinline__ bool tile_of(long L, int nM, int nN, int& pm, int& pn, int wgm = WGM) {
    const int nwg = nM * nN; if (L >= nwg) return false;
    int wgid = (int)L; { const int q = nwg / NXCD, r = nwg % NXCD, xcd = wgid % NXCD, off = wgid / NXCD; wgid = (xcd < r ? xcd * (q + 1) : r * (q + 1) + (xcd - r) * q) + off; }
    const int nig = wgm * nN, gid = wgid / nig, fm = gid * wgm, gsz = (nM - fm) < wgm ? (nM - fm) : wgm;
    pm = fm + ((wgid % nig) % gsz); pn = (wgid % nig) / gsz; return true;
}
struct DenseOrder {
    const char* A; const char* Bt; int nM, nN, G, c, wgm = WGM; size_t tstep;
    __device__ __forceinline__ void init(const void* A_, const void* Bt_, int M, int N, int KB, int G_, int c_) { A = (const char*)A_; Bt = (const char*)Bt_; nM = M / BM; nN = N / BM; G = G_; c = c_; tstep = (size_t)BM * KB; }
    __device__ __forceinline__ bool next(int i, Unit& u) const {
        int pm, pn; if (!tile_of((long)i * G + c, nM, nN, pm, pn, wgm)) return false;
        u.pm = pm; u.pn = pn; u.e = 0; u.pad = 0; u.a = A + (size_t)pm * tstep; u.b = Bt + (size_t)pn * tstep; return true; }
    __device__ __forceinline__ void a_ready(const Unit&) const {}
    __device__ __forceinline__ void done(const Unit&) const {}
};
struct MoeOrder {
    const char* A; const char* Bt; const LAS int* tp; int nM, nN, G, c, wgm = WGM_MOE; size_t tstep, estep;
    int lim = 0x7fffffff;
    const int* rowtok = nullptr; LAS unsigned* ids = nullptr;
    __device__ __forceinline__ void init(const void* A_, const void* Bt_, const LAS int* tp_, int ntiles, int N, int KB, int G_, int c_) {
        A = (const char*)A_; Bt = (const char*)Bt_; tp = tp_; nM = ntiles; nN = N / BM; G = G_; c = c_; tstep = (size_t)BM * KB; estep = (size_t)N * KB; }
    __device__ __forceinline__ bool next(int i, Unit& u) const {
        int pm, pn; if ((long)i * G + c >= lim || !tile_of((long)i * G + c, nM, nN, pm, pn, wgm)) return false;
        const int lane = hw_lane(); const int v = (lane < 32) ? tp[lane + 1] : 0x7fffffff;
        const int e = __popcll(__ballot(v <= pm));
        u.pm = pm; u.pn = pn; u.e = e; u.pad = 0; u.a = rowtok ? A : A + (size_t)pm * tstep; u.b = Bt + (size_t)e * estep + (size_t)pn * tstep; return true; }
    __device__ __forceinline__ void a_ready(const Unit&) const {}
    __device__ __forceinline__ void done(const Unit&) const {}
};

struct MoeHalfOrder {
    const char* A; const char* Bt; const LAS int* tp; int nM, nN, c, l0, R, wgm = WGM_MOE, KB; size_t tstep, estep;
    __device__ __forceinline__ void init(const void* A_, const void* Bt_, const LAS int* tp_, int ntiles, int N, int KB_, int c_, int l0_, int R_) {
        A = (const char*)A_; Bt = (const char*)Bt_; tp = tp_; nM = ntiles; nN = N / BM; c = c_; l0 = l0_; R = R_; KB = KB_; tstep = (size_t)BM * KB_; estep = (size_t)N * KB_; }
    __device__ __forceinline__ bool next(int i, Unit& u) const {
        int pm, pn; if (i > 0 || c >= 2 * R || !tile_of((long)l0 + (c >> 1), nM, nN, pm, pn, wgm)) return false;
        const int lane = hw_lane(); const int v = (lane < 32) ? tp[lane + 1] : 0x7fffffff;
        const int e = __popcll(__ballot(v <= pm)), ro = (c & 1) * HALF;
        u.pm = pm; u.pn = pn; u.e = e; u.pad = ro; u.a = A + (size_t)pm * tstep + (size_t)ro * KB; u.b = Bt + (size_t)e * estep + (size_t)pn * tstep; return true; }
    __device__ __forceinline__ void a_ready(const Unit&) const {}
    __device__ __forceinline__ void done(const Unit&) const {}
};

struct QueueOrder {
    const char* A; const char* Bt; int nM, nN, nwg, per, x0, wave; size_t tstep; unsigned* head; volatile LAS unsigned* slot;
    mutable int k, seq;
    __device__ __forceinline__ void init(const void* A_, const void* Bt_, int M, int N, int KB, unsigned* head_, volatile LAS unsigned* slot_, int xcd, int wave_) {
        A = (const char*)A_; Bt = (const char*)Bt_; nM = M / BM; nN = N / BM; tstep = (size_t)BM * KB; slot = slot_; head = head_;
        nwg = nM * nN; per = (nwg + NXCD - 1) / NXCD; x0 = xcd & (NXCD - 1); k = 0; seq = 0; wave = wave_; }
    __device__ __forceinline__ bool next(int, Unit& u) const {
        int L;
        for (;;) {
            if (k >= NXCD) return false;
            const int q = (x0 + k) & (NXCD - 1), lo = q * per, hi = lo + per < nwg ? lo + per : nwg;
            if (wave == 0) {
                if (hw_lane() == 0) slot[seq & 1] = __hip_atomic_fetch_add(head + 64 * q, 1u, __ATOMIC_RELAXED, __HIP_MEMORY_SCOPE_AGENT);
                asm volatile("s_waitcnt vmcnt(0) lgkmcnt(0)" ::: "memory");
            }
            asm volatile("" ::: "memory"); __builtin_amdgcn_s_barrier(); asm volatile("" ::: "memory");
            L = lo + __builtin_amdgcn_readfirstlane((int)slot[seq & 1]); ++seq;
            if (L < hi) break;
            ++k;
        }
        const int nig = WGM_Q * nN, gid = L / nig, fm = gid * WGM_Q, gsz = (nM - fm) < WGM_Q ? (nM - fm) : WGM_Q;
        const int pm = fm + ((L % nig) % gsz), pn = (L % nig) / gsz;
        u.pm = pm; u.pn = pn; u.e = 0; u.pad = 0; u.a = A + (size_t)pm * tstep; u.b = Bt + (size_t)pn * tstep; return true; }
    __device__ __forceinline__ void a_ready(const Unit&) const {}
    __device__ __forceinline__ void done(const Unit&) const {}
};

typedef f32x4 Acc[2][2][4][2];
__device__ __forceinline__ f32x2 gelu_pk(f32x2 v) {
    const f32x2 av = __builtin_elementwise_abs(v), d = av * 0.2316418882f + 1.0f;
    f32x2 t; t.x = __builtin_amdgcn_rcpf(d.x); t.y = __builtin_amdgcn_rcpf(d.y);
    f32x2 q = t * 0.5307027145f + (-0.7265760135f); q = q * t + 0.7107068705f; q = q * t + (-0.142248368f); q = q * t + 0.127414796f; q = q * t;
    const f32x2 s = (v * v) * (-0.72134752044f);
    f32x2 e; e.x = __builtin_amdgcn_exp2f(s.x); e.y = __builtin_amdgcn_exp2f(s.y);
    const f32x2 m = v * (q * e), r = v - m;
    f32x2 o; o.x = v.x < 0.f ? m.x : r.x; o.y = v.y < 0.f ? m.y : r.y; return o;
}

__device__ __forceinline__ unsigned pk4_fp8(float a, float b, float c, float d) { int w = 0; w = __builtin_amdgcn_cvt_pk_fp8_f32(a, b, w, false); w = __builtin_amdgcn_cvt_pk_fp8_f32(c, d, w, true); return (unsigned)w; }
__device__ __forceinline__ float clamp448(float v) { return fminf(fmaxf(v, -448.0f), 448.0f); }
constexpr float SC_X1 = 16.0f, SC_WGU = 512.0f, SC_H = 4.0f, SC_WD = 1024.0f;
constexpr float SC_MRG = 16.0f, SC_WO = 1024.0f;
constexpr float SC_Y = 128.0f;
__device__ __forceinline__ float sat448(float v) { return __builtin_amdgcn_fmed3f(v, -448.0f, 448.0f); }
__device__ __forceinline__ float sat8(float v) { return __builtin_amdgcn_fmed3f(v * SC_MRG, -448.0f, 448.0f); }
struct EpiIn {
    struct Pre {}; __device__ __forceinline__ void prefetch(Pre&, const Unit&, int, int, int, int) const {}
    static constexpr bool PERM = true, AFTER_DRAIN = false;
    bf16 *QB, *KB, *VB, *ZB, *GT; const float* cs; int pn_off; float sc;
    __device__ __forceinline__ void operator()(const Acc& acc, const Unit& u, int wr, int wc, int fr, int fq, const Pre&) const {
        const int pn = (pn_off == 0 && u.pn >= 18) ? u.pn + 8 : u.pn + pn_off; bf16* base; int ldc, colt, mode;
        if (pn < 6) { base = QB; ldc = AW; colt = 256 * pn; mode = 1; }
        else if (pn < 12) { base = KB; ldc = AW; colt = 256 * (pn - 6); mode = 1; }
        else if (pn < 18) { base = VB; ldc = AW; colt = 256 * (pn - 12); mode = 0; }
        else if (pn < 26) { base = ZB; ldc = 2048; colt = 256 * (pn - 18); mode = 2; }
        else { base = GT; ldc = 4096; colt = 256 * (pn - 26); mode = 3; }
        const int row0 = u.pm * BM + wr * 64 + fr, col0 = colt + wc * 32 + 8 * fq;
        const bool rope = (mode == 1) && (wc == 0);
#pragma unroll
        for (int ai = 0; ai < 2; ++ai)
#pragma unroll
            for (int m = 0; m < 4; ++m) {
                const int row = row0 + ai * HALF + m * 16;
                f32x4 cs4[4];
                if (rope) { const f32x4* cp = (const f32x4*)(cs + ((size_t)row * 16 + 8 * (fq & 1)) * 2);
#pragma unroll
                    for (int q = 0; q < 4; ++q) cs4[q] = cp[q]; }
                bf16* rowp = base + (size_t)row * ldc + col0;
#pragma unroll
                for (int bj = 0; bj < 2; ++bj) {
                    f32x4 v0 = acc[ai][bj][m][0] * sc, v1 = acc[ai][bj][m][1] * sc;
                    if (rope) {
                        float x[8] = {v0[0], v0[1], v0[2], v0[3], v1[0], v1[1], v1[2], v1[3]};
#pragma unroll
                        for (int i = 0; i < 8; ++i) {
                            const float y = __shfl_xor(x[i], 32);
                            const float c = cs4[i >> 1][(i & 1) * 2], s = cs4[i >> 1][(i & 1) * 2 + 1];
                            x[i] = (fq < 2) ? (x[i] * c - y * s) : (x[i] * c + y * s);
                        }
                        v0 = (f32x4){x[0], x[1], x[2], x[3]}; v1 = (f32x4){x[4], x[5], x[6], x[7]};
                    }
                    if (mode == 2) { f32x2 a = gelu_pk((f32x2){v0[0], v0[1]}), b = gelu_pk((f32x2){v0[2], v0[3]}), c = gelu_pk((f32x2){v1[0], v1[1]}), d = gelu_pk((f32x2){v1[2], v1[3]});
                        v0 = (f32x4){a.x, a.y, b.x, b.y}; v1 = (f32x4){c.x, c.y, d.x, d.y}; }
                    if (mode == 3) {
                        const float ce = -1.44269504089f * sc;
                        const f32x4 a0 = acc[ai][bj][m][0], a1 = acc[ai][bj][m][1];
                        const f32x2 e0 = (f32x2){a0[0], a0[1]} * ce, e1 = (f32x2){a0[2], a0[3]} * ce, e2 = (f32x2){a1[0], a1[1]} * ce, e3 = (f32x2){a1[2], a1[3]} * ce;
                        f32x2 t0, t1, t2, t3;
                        t0.x = __builtin_amdgcn_exp2f(e0.x); t0.y = __builtin_amdgcn_exp2f(e0.y); t1.x = __builtin_amdgcn_exp2f(e1.x); t1.y = __builtin_amdgcn_exp2f(e1.y);
                        t2.x = __builtin_amdgcn_exp2f(e2.x); t2.y = __builtin_amdgcn_exp2f(e2.y); t3.x = __builtin_amdgcn_exp2f(e3.x); t3.y = __builtin_amdgcn_exp2f(e3.y);
                        t0 = t0 + 1.0f; t1 = t1 + 1.0f; t2 = t2 + 1.0f; t3 = t3 + 1.0f;
                        v0 = (f32x4){__builtin_amdgcn_rcpf(t0.x), __builtin_amdgcn_rcpf(t0.y), __builtin_amdgcn_rcpf(t1.x), __builtin_amdgcn_rcpf(t1.y)};
                        v1 = (f32x4){__builtin_amdgcn_rcpf(t2.x), __builtin_amdgcn_rcpf(t2.y), __builtin_amdgcn_rcpf(t3.x), __builtin_amdgcn_rcpf(t3.y)}; }
                    u32x4 w; w.x = cvt_pk_bf16(v0[0], v0[1]); w.y = cvt_pk_bf16(v0[2], v0[3]); w.z = cvt_pk_bf16(v1[0], v1[1]); w.w = cvt_pk_bf16(v1[2], v1[3]);
                    *(u32x4*)(rowp + bj * HALF) = w;
                }
            }
    }
};
template <bool OUT8>
struct EpiGateT {
    struct Pre {}; __device__ __forceinline__ void prefetch(Pre&, const Unit&, int, int, int, int) const {}
    static constexpr bool PERM = true, AFTER_DRAIN = false;
    bf16* MRG; const bf16* GT; int goff; int accum; unsigned char* MRG8;
    __device__ __forceinline__ void operator()(const Acc& acc, const Unit& u, int wr, int wc, int fr, int fq, const Pre&) const {
        const int row0 = u.pm * BM + wr * 64 + fr, col0 = u.pn * BM + wc * 32 + 8 * fq;
#pragma unroll
        for (int ai = 0; ai < 2; ++ai)
#pragma unroll
            for (int m = 0; m < 4; ++m) {
                const int row = row0 + ai * HALF + m * 16;
#pragma unroll
                for (int bj = 0; bj < 2; ++bj) {
                    const int col = col0 + bj * HALF;
                    const u32x4 g = *(const u32x4*)(GT + (size_t)row * 4096 + goff + col);
                    bf16* op = MRG + (size_t)row * D + col;
                    f32x4 v0 = acc[ai][bj][m][0], v1 = acc[ai][bj][m][1];
                    v0[0] *= bflo(g.x); v0[1] *= bfhi(g.x); v0[2] *= bflo(g.y); v0[3] *= bfhi(g.y);
                    v1[0] *= bflo(g.z); v1[1] *= bfhi(g.z); v1[2] *= bflo(g.w); v1[3] *= bfhi(g.w);
                    if (accum) { const u32x4 o = *(const u32x4*)op;
                        v0[0] += bflo(o.x); v0[1] += bfhi(o.x); v0[2] += bflo(o.y); v0[3] += bfhi(o.y);
                        v1[0] += bflo(o.z); v1[1] += bfhi(o.z); v1[2] += bflo(o.w); v1[3] += bfhi(o.w); }
                    if constexpr (OUT8) {
                        u32x2 w; w.x = pk4_fp8(sat8(v0[0]), sat8(v0[1]), sat8(v0[2]), sat8(v0[3])); w.y = pk4_fp8(sat8(v1[0]), sat8(v1[1]), sat8(v1[2]), sat8(v1[3]));
                        *(u32x2*)(MRG8 + (size_t)row * D + col) = w; }
                    else { u32x4 w; w.x = cvt_pk_bf16(v0[0], v0[1]); w.y = cvt_pk_bf16(v0[2], v0[3]); w.z = cvt_pk_bf16(v1[0], v1[1]); w.w = cvt_pk_bf16(v1[2], v1[3]);
                        *(u32x4*)op = w; }
                }
            }
    }
};
struct EpiX1 {
    struct Pre {}; __device__ __forceinline__ void prefetch(Pre&, const Unit&, int, int, int, int) const {}
    static constexpr bool PERM = true, AFTER_DRAIN = false;
    const bf16* xb; bf16* X1F; float sc;
    __device__ __forceinline__ void operator()(const Acc& acc, const Unit& u, int wr, int wc, int fr, int fq, const Pre&) const {
        const int row0 = u.pm * BM + wr * 64 + fr, col0 = u.pn * BM + wc * 32 + 8 * fq;
#pragma unroll
        for (int ai = 0; ai < 2; ++ai)
#pragma unroll
            for (int m = 0; m < 4; ++m) { const size_t off = (size_t)(row0 + ai * HALF + m * 16) * D + col0;
#pragma unroll
                for (int bj = 0; bj < 2; ++bj) { const u32x4 xv = *(const u32x4*)(xb + off + bj * HALF);
                    f32x4 v0 = acc[ai][bj][m][0] * sc, v1 = acc[ai][bj][m][1] * sc;
                    v0[0] += ALPHA * bflo(xv.x); v0[1] += ALPHA * bfhi(xv.x); v0[2] += ALPHA * bflo(xv.y); v0[3] += ALPHA * bfhi(xv.y);
                    v1[0] += ALPHA * bflo(xv.z); v1[1] += ALPHA * bfhi(xv.z); v1[2] += ALPHA * bflo(xv.w); v1[3] += ALPHA * bfhi(xv.w);
                    u32x4 w; w.x = cvt_pk_bf16(v0[0], v0[1]); w.y = cvt_pk_bf16(v0[2], v0[3]); w.z = cvt_pk_bf16(v1[0], v1[1]); w.w = cvt_pk_bf16(v1[2], v1[3]);
                    *(u32x4*)(X1F + off + bj * HALF) = w; } }
    }
};
struct EpiSwiglu8 {
    struct Pre { f32x4 bg0, bg1, bu0, bu1; };
    static constexpr bool PERM = true, AFTER_DRAIN = false;
    unsigned char* HB8; const float* bgu;
    __device__ __forceinline__ void prefetch(Pre& P, const Unit& u, int wr, int wc, int fr, int fq) const {
        const float* bg = bgu + (size_t)u.e * (2 * DE) + u.pn * HALF + wc * 32 + 8 * fq;
        P.bg0 = *(const f32x4*)bg; P.bg1 = *(const f32x4*)(bg + 4); P.bu0 = *(const f32x4*)(bg + DE); P.bu1 = *(const f32x4*)(bg + DE + 4); }
    __device__ __forceinline__ void operator()(const Acc& acc, const Unit& u, int wr, int wc, int fr, int fq, const Pre& P) const {
        const int row0 = u.pm * BM + wr * 64 + fr, ch0 = u.pn * HALF + wc * 32 + 8 * fq;
        const float isc = 1.0f / (SC_X1 * SC_WGU), ce = -1.702f * 1.44269504089f, qh = 1.0f / SC_H;
        const f32x2 bg[4] = {(f32x2){P.bg0[0], P.bg0[1]}, (f32x2){P.bg0[2], P.bg0[3]}, (f32x2){P.bg1[0], P.bg1[1]}, (f32x2){P.bg1[2], P.bg1[3]}};
        const f32x2 bu[4] = {(f32x2){P.bu0[0] + 1.0f, P.bu0[1] + 1.0f}, (f32x2){P.bu0[2] + 1.0f, P.bu0[3] + 1.0f}, (f32x2){P.bu1[0] + 1.0f, P.bu1[1] + 1.0f}, (f32x2){P.bu1[2] + 1.0f, P.bu1[3] + 1.0f}};
#pragma unroll
        for (int ai = 0; ai < 2; ++ai)
#pragma unroll
            for (int m = 0; m < 4; ++m) {
                const int row = row0 + ai * HALF + m * 16;
                f32x2 h[4];
#pragma unroll
                for (int p = 0; p < 4; ++p) {
                    const f32x4 ag = acc[ai][0][m][p >> 1], au = acc[ai][1][m][p >> 1];
                    f32x2 g = (f32x2){ag[2 * (p & 1)], ag[2 * (p & 1) + 1]} * isc + bg[p];
                    f32x2 u1 = (f32x2){au[2 * (p & 1)], au[2 * (p & 1) + 1]} * isc + bu[p];
                    g = __builtin_elementwise_min(g, (f32x2){7.0f, 7.0f});
                    u1 = __builtin_elementwise_min(__builtin_elementwise_max(u1, (f32x2){-6.0f, -6.0f}), (f32x2){8.0f, 8.0f});
                    const f32x2 ge = g * ce;
                    f32x2 t; t.x = __builtin_amdgcn_exp2f(ge.x); t.y = __builtin_amdgcn_exp2f(ge.y);
                    const f32x2 d = t * qh + qh;
                    f32x2 s; s.x = __builtin_amdgcn_rcpf(d.x); s.y = __builtin_amdgcn_rcpf(d.y);
                    h[p] = (u1 * g) * s;
                }
                u32x2 w; w.x = pk4_fp8(h[0].x, h[0].y, h[1].x, h[1].y); w.y = pk4_fp8(h[2].x, h[2].y, h[3].x, h[3].y);
                *(u32x2*)(HB8 + (size_t)row * DE + ch0) = w;
            }
    }
};
struct EpiDown {
    struct Pre {};
    static constexpr bool PERM = true, AFTER_DRAIN = false;
    unsigned char* YB; const float* bd; const float* rgate; float isc; LAS float* epi;
    __device__ __forceinline__ void prefetch(Pre&, const Unit& u, int wr, int wc, int fr, int fq) const {
        const int wid = wr * 4 + wc, lane = fq * 16 + fr;
        const float* src = (wid < 4) ? (rgate + u.pm * BM + u.pad + 64 * wid + lane) : (bd + (size_t)u.e * D + u.pn * BM + 64 * (wid - 4) + lane);
        __builtin_amdgcn_global_load_lds((const unsigned*)src, (LAS unsigned*)(epi + 64 * wid), 4, 0, 0);
    }
    __device__ __forceinline__ void operator()(const Acc& acc, const Unit& u, int wr, int wc, int fr, int fq, const Pre& p) const { run<2>(acc, u, wr, wc, fr, fq, p); }
    __device__ __forceinline__ void half(const Acc& acc, const Unit& u, int wr, int wc, int fr, int fq, const Pre& p) const { run<1>(acc, u, wr, wc, fr, fq, p); }
    template <int NAI>
    __device__ __forceinline__ void run(const Acc& acc, const Unit& u, int wr, int wc, int fr, int fq, const Pre&) const {
        const int row0 = u.pm * BM + u.pad + wr * 64 + fr, col0 = u.pn * BM + wc * 32 + 8 * fq;
        f32x4 bv[2][2];
#pragma unroll
        for (int bj = 0; bj < 2; ++bj)
#pragma unroll
            for (int n = 0; n < 2; ++n) bv[bj][n] = *(const LAS f32x4*)(epi + 256 + wc * 32 + 8 * fq + bj * HALF + 4 * n);
#pragma unroll
        for (int ai = 0; ai < NAI; ++ai)
#pragma unroll
            for (int m = 0; m < 4; ++m) {
                const int row = row0 + ai * HALF + m * 16; const float gt = epi[wr * 64 + fr + ai * HALF + m * 16] * SC_Y;
#pragma unroll
                for (int bj = 0; bj < 2; ++bj) {
                    const f32x4 v0 = (acc[ai][bj][m][0] * isc + bv[bj][0]) * gt, v1 = (acc[ai][bj][m][1] * isc + bv[bj][1]) * gt;
                    u32x2 w; w.x = pk4_fp8(sat448(v0[0]), sat448(v0[1]), sat448(v0[2]), sat448(v0[3])); w.y = pk4_fp8(sat448(v1[0]), sat448(v1[1]), sat448(v1[2]), sat448(v1[3]));
                    *(u32x2*)(YB + (size_t)row * D + col0 + bj * HALF) = w;
                }
            }
    }
};

typedef int i32x8 __attribute__((ext_vector_type(8)));
typedef short s16x16 __attribute__((ext_vector_type(16)));
typedef int i32x4 __attribute__((ext_vector_type(4)));
__device__ __forceinline__ bf16x8 lo8(i32x8 v) { return __builtin_bit_cast(bf16x8, __builtin_shufflevector(v, v, 0, 1, 2, 3)); }
__device__ __forceinline__ bf16x8 hi8(i32x8 v) { return __builtin_bit_cast(bf16x8, __builtin_shufflevector(v, v, 4, 5, 6, 7)); }
__device__ __forceinline__ void mfma_fp8(f32x4& c, const i32x8& a, const i32x8& b) { asm volatile("v_mfma_f32_16x16x128_f8f6f4 %0, %1, %2, %0" : "+v"(c) : "v"(a), "v"(b)); }
template <class Epi, class Sched, bool FP8 = false, bool ALIGN_EPI = true, bool GATHER = false, bool HALFM = false>
__device__ __forceinline__ void gemm_phase(LAS unsigned char* lds, const int KB, const Sched& S, const Epi& E, const int wave) {
    const int lane = hw_lane(), wid = wave, tid = wid * 64 + lane,
              wr = wid >> 2, wc = wid & 3, fr = lane & 15, fq = lane >> 4;
    const int nt = KB / 128;
    unsigned voffA[2], voffB[2];
#pragma unroll
    for (int i = 0; i < 2; ++i) { int R, C; stage_rc(tid * 16 + i * 8192, R, C); const int Rb = Epi::PERM ? ((R & ~31) + perm32(R & 31)) : R;
        voffA[i] = (unsigned)(R * KB + C * 2); voffB[i] = (unsigned)(Rb * KB + C * 2); }
    const size_t kstep = (size_t)(BK * 2);
    const size_t hstep = (size_t)HALF * KB;
    const unsigned ldsw = (unsigned)wid * 1024u;
    const int aoff = lds_byte(wr * 64 + fr, fq * 8), boff = lds_byte(wc * 32 + fr, fq * 8);
#define PG8_SA(b, h) (((b) * 2 + (h)) * HTB)
#define PG8_SB(b, h) ((4 + (b) * 2 + (h)) * HTB)
#define PG8_STAGE(bufoff, gbase, voff) do { _Pragma("unroll") for (int _i = 0; _i < 2; ++_i) \
        __builtin_amdgcn_global_load_lds((const unsigned*)((const char*)(gbase) + (voff)[_i]), (LAS unsigned*)(lds + (bufoff) + ldsw + _i * 8192), 16, 0, 0); } while (0)
#define PG8_STA(bufoff, kp, h) do { if constexpr (GATHER) { _Pragma("unroll") for (int _i = 0; _i < 2; ++_i) \
        __builtin_amdgcn_global_load_lds((const unsigned*)((const char*)(kp) + gc[h][_i]), (LAS unsigned*)(lds + (bufoff) + ldsw + _i * 8192), 16, 0, 0); } \
        else { PG8_STAGE(bufoff, (kp) + (h) * hstep, voffA); } } while (0)
#define PG8_GFETCH(u) do { if constexpr (GATHER) { if (wid < 4) __builtin_amdgcn_global_load_lds((const unsigned*)(S.rowtok + (u).pm * BM + 64 * wid + lane), (LAS unsigned*)(S.ids + 64 * wid), 4, 0, 0); } } while (0)
#define PG8_GREAD() do { if constexpr (GATHER) { _Pragma("unroll") for (int _h = 0; _h < 2; ++_h) _Pragma("unroll") for (int _i = 0; _i < 2; ++_i) { int R_, C_; stage_rc(tid * 16 + _i * 8192, R_, C_); \
        gc[_h][_i] = S.ids[_h * HALF + R_] * (unsigned)KB + (unsigned)(C_ * 2); } } } while (0)
#define PG8_LDA(dst, b, h) do { _Pragma("unroll") for (int m = 0; m < 4; ++m) { const i32x4 _l = *(const LAS i32x4*)(lds + PG8_SA(b, h) + aoff + m * 2048), _h = *(const LAS i32x4*)(lds + PG8_SA(b, h) + aoff + m * 2048 + 1024); \
        dst[m] = __builtin_shufflevector(_l, _h, 0, 1, 2, 3, 4, 5, 6, 7); } } while (0)
#define PG8_LDB(dst, b, h) do { _Pragma("unroll") for (int n = 0; n < 2; ++n) { const i32x4 _l = *(const LAS i32x4*)(lds + PG8_SB(b, h) + boff + n * 2048), _h = *(const LAS i32x4*)(lds + PG8_SB(b, h) + boff + n * 2048 + 1024); \
        dst[n] = __builtin_shufflevector(_l, _h, 0, 1, 2, 3, 4, 5, 6, 7); } } while (0)
#define PG8_MMA(ai, bj, At, Bt) do { __builtin_amdgcn_s_setprio(1); _Pragma("unroll") for (int m = 0; m < 4; ++m) _Pragma("unroll") for (int n = 0; n < 2; ++n) { \
        if constexpr (FP8) { mfma_fp8(acc[ai][bj][m][n], Bt[n], At[m]); } \
        else { acc[ai][bj][m][n] = __builtin_amdgcn_mfma_f32_16x16x32_bf16(lo8(Bt[n]), lo8(At[m]), acc[ai][bj][m][n], 0, 0, 0); \
               acc[ai][bj][m][n] = __builtin_amdgcn_mfma_f32_16x16x32_bf16(hi8(Bt[n]), hi8(At[m]), acc[ai][bj][m][n], 0, 0, 0); } } __builtin_amdgcn_s_setprio(0); } while (0)
#define PG8_WAIT_V(n) asm volatile("s_waitcnt vmcnt(" #n ")" ::: "memory")
#define PG8_WAIT_L(n) asm volatile("s_waitcnt lgkmcnt(" #n ")" ::: "memory")
#define PG8_BAR __builtin_amdgcn_s_barrier()
#define PG8_SCHED __builtin_amdgcn_sched_barrier(0)
    Unit cur, nxt; int ui = 0;
    if (!S.next(0, cur)) return;
    f32x4 acc[2][2][4][2];
#pragma unroll
    for (int a = 0; a < 2; ++a)
#pragma unroll
        for (int b = 0; b < 2; ++b)
#pragma unroll
            for (int m = 0; m < 4; ++m)
#pragma unroll
                for (int n = 0; n < 2; ++n) acc[a][b][m][n] = (f32x4){0.f, 0.f, 0.f, 0.f};
    typename Epi::Pre pre;
    i32x8 At[4], B0[2], B1[2];
    const char* cA = cur.a; const char* cB = cur.b;
    S.a_ready(cur);
    unsigned gc[2][2] = {{0u, 0u}, {0u, 0u}};
    if constexpr (GATHER) { PG8_GFETCH(cur); PG8_WAIT_V(0); PG8_BAR; PG8_GREAD(); PG8_WAIT_L(0); PG8_BAR; }
    PG8_STAGE(PG8_SB(0, 0), cB, voffB); PG8_STAGE(PG8_SB(0, 1), cB + hstep, voffB); PG8_STA(PG8_SA(0, 0), cA, 0); PG8_STA(PG8_SA(0, 1), cA, 1);
    if (wr == 1) PG8_BAR;
    PG8_WAIT_V(2); PG8_BAR;
    PG8_STAGE(PG8_SB(1, 0), cB + kstep, voffB); PG8_STA(PG8_SA(1, 0), cA + kstep, 0); PG8_STAGE(PG8_SB(1, 1), cB + hstep + kstep, voffB);
    PG8_WAIT_V(6); PG8_BAR;
    for (;;) {
        const bool has_next = S.next(ui + 1, nxt);
        const char* nA = has_next ? nxt.a : cA; const char* nB = has_next ? nxt.b : cB;
        if (has_next) PG8_GFETCH(nxt);
        for (int t = 0; t < nt; t += 2) {
            const bool last = (t == nt - 2);
            const char* a1 = cA + (size_t)(t + 1) * kstep;
            const char* a2 = last ? nA : cA + (size_t)(t + 2) * kstep; const char* b2 = last ? nB : cB + (size_t)(t + 2) * kstep;
            const char* a3 = a2 + kstep; const char* b3 = b2 + kstep;
            if (last && has_next) S.a_ready(nxt);
            if (last) E.prefetch(pre, cur, wr, wc, fr, fq);
            PG8_LDB(B0, 0, 0); PG8_LDB(B1, 0, 1); PG8_SCHED; PG8_LDA(At, 0, 0); PG8_STA(PG8_SA(1, 1), a1, 1);
            if constexpr (GATHER) { if (last && has_next) PG8_GREAD(); }
            PG8_WAIT_V(8); PG8_WAIT_L(0); PG8_BAR; PG8_MMA(0, 0, At, B0); PG8_MMA(0, 1, At, B1); PG8_BAR; PG8_SCHED;
            if constexpr (!HALFM) PG8_LDA(At, 0, 1); PG8_STAGE(PG8_SB(0, 0), b2, voffB); PG8_STAGE(PG8_SB(0, 1), b2 + hstep, voffB); PG8_STA(PG8_SA(0, 0), a2, 0);
            PG8_WAIT_V(8); PG8_WAIT_L(0); PG8_BAR; if constexpr (!HALFM) { PG8_MMA(1, 0, At, B0); PG8_MMA(1, 1, At, B1); } PG8_BAR; PG8_SCHED;
            PG8_LDB(B0, 1, 0); PG8_LDB(B1, 1, 1); PG8_SCHED; PG8_LDA(At, 1, 0); PG8_STA(PG8_SA(0, 1), a2, 1);
            PG8_WAIT_V(8); PG8_WAIT_L(0); PG8_BAR; PG8_MMA(0, 0, At, B0); PG8_MMA(0, 1, At, B1); PG8_BAR; PG8_SCHED;
            if constexpr (!HALFM) PG8_LDA(At, 1, 1); PG8_STAGE(PG8_SB(1, 0), b3, voffB); PG8_STAGE(PG8_SB(1, 1), b3 + hstep, voffB); PG8_STA(PG8_SA(1, 0), a3, 0);
            PG8_WAIT_V(8); PG8_WAIT_L(0); PG8_BAR; if constexpr (!HALFM) { PG8_MMA(1, 0, At, B0); PG8_MMA(1, 1, At, B1); } PG8_BAR; PG8_SCHED;
        }
        if constexpr (ALIGN_EPI) { if (wr == 0) PG8_BAR; }
        { const int te = hw_lane();
          if constexpr (HALFM) E.half(acc, cur, wr, wc, te & 15, te >> 4, pre); else E(acc, cur, wr, wc, te & 15, te >> 4, pre); } S.done(cur);
        if (!has_next) break;
#pragma unroll
        for (int a = 0; a < 2; ++a)
#pragma unroll
            for (int b = 0; b < 2; ++b)
#pragma unroll
                for (int m = 0; m < 4; ++m)
#pragma unroll
                    for (int n = 0; n < 2; ++n) acc[a][b][m][n] = (f32x4){0.f, 0.f, 0.f, 0.f};
        cur = nxt; cA = nA; cB = nB; ++ui;
        if constexpr (ALIGN_EPI) { if (wr == 1) PG8_BAR; }
    }
    PG8_WAIT_V(0);
    if constexpr (!ALIGN_EPI) { if (wr == 0) PG8_BAR; }
    PG8_BAR;
#undef PG8_SA
#undef PG8_SB
#undef PG8_STAGE
#undef PG8_LDA
#undef PG8_STA
#undef PG8_GFETCH
#undef PG8_GREAD
#undef PG8_LDB
#undef PG8_MMA
#undef PG8_WAIT_V
#undef PG8_WAIT_L
#undef PG8_BAR
#undef PG8_SCHED
}
}

struct Args { const void* in[20]; float* out; unsigned char* ws; int ph_lo, ph_hi; };
struct Frame {
    LAS unsigned char* lds;
    int tid, lane, wave, G, bx;
    int c, GG;
    unsigned char* ws;
    unsigned* ctl;
};
#define WSP(T, off) ((T*)(F.ws + (off)))
#define B_XB WSP(bf16, WS_XB)
#define B_WIN WSP(bf16, WS_WIN)
#define B_WA WSP(bf16, WS_WA)
#define B_WB WSP(bf16, WS_WB)
#define B_WO WSP(bf16, WS_WO)
#define B_WGU8 WSP(unsigned char, WS_WGU)
#define B_WD8 WSP(unsigned char, WS_WD)
#define B_SGW WSP(bf16, WS_SGW)
#define B_CS WSP(float, WS_CS)
#define B_WRT WSP(bf16, WS_WRT)
#define B_X8 WSP(unsigned char, WS_X8)
#define B_WIN8 WSP(unsigned char, WS_WIN8)
#define B_VST WSP(float, WS_VST)
#define B_QB WSP(bf16, WS_QB)
#define B_KB WSP(bf16, WS_KB)
#define B_VB WSP(bf16, WS_VB)
#define B_ZB WSP(bf16, WS_ZB)
#define B_GT WSP(bf16, WS_GT)
#define B_OG WSP(bf16, WS_OG)
#define B_LSE WSP(float, WS_LSE)
#define B_OA WSP(bf16, WS_OA)
#define B_SGI WSP(bf16, WS_SGI)
#define B_MRG WSP(bf16, WS_MRG)
#define B_X1F WSP(bf16, WS_X1F)
#define B_X1Q WSP(unsigned char, WS_X1B)
#define B_MRG8 WSP(unsigned char, WS_X1B + 32 * MiB)
#define B_WO8 WSP(unsigned char, WS_WO)
#define B_LN1ST WSP(float, WS_VST)
#define B_X1H WSP(bf16, WS_MRG)
#define B_CNTWG WSP(int, WS_STOK)
#define B_TGATE WSP(float, WS_SGATE)
#define B_INV WSP(int, WS_INV)
#define B_RGATE WSP(float, WS_RGATE)
#define B_ROWTOK WSP(int, WS_STOK + 1 * MiB)
#define B_TPG WSP(int, WS_RGATE + 512 * 1024)
#define B_XS8 WSP(unsigned char, WS_XS)
#define B_HB8 WSP(unsigned char, WS_HB)
#define B_YB WSP(unsigned char, WS_YB)

__device__ __forceinline__ unsigned off_b(unsigned row, unsigned ch) { return 256u * row + 16u * (ch ^ (((row & 3) << 2) | ((row >> 2) & 3))); }
__device__ __forceinline__ unsigned tr_addr16(unsigned lane, unsigned c, unsigned ks, unsigned t) {
    const unsigned g = lane >> 4, q = (lane & 15) >> 2, p = lane & 3;
    return off_b(32 * ks + 8 * g + 4 * t + q, 2 * c + (p >> 1)) + 8 * (p & 1);
}
template <int OFF>
__device__ __forceinline__ bf16x8 tr_read2(unsigned a0, unsigned a1) {
    s16x4 lo, hi;
    asm volatile("ds_read_b64_tr_b16 %0, %2 offset:%4\n\tds_read_b64_tr_b16 %1, %3 offset:%4\n\ts_waitcnt lgkmcnt(0)" : "=&v"(lo), "=&v"(hi) : "v"(a0), "v"(a1), "i"(OFF) : "memory");
    bf16x8 r; r[0] = lo[0]; r[1] = lo[1]; r[2] = lo[2]; r[3] = lo[3]; r[4] = hi[0]; r[5] = hi[1]; r[6] = hi[2]; r[7] = hi[3]; return r;
}

template <int OFF>
__device__ __forceinline__ void tr_read16(const unsigned (&a)[8][2], bf16x8 (&f)[8]) {
    s16x4 r[16];
    asm volatile("ds_read_b64_tr_b16 %0, %16 offset:%32\n\tds_read_b64_tr_b16 %1, %17 offset:%32\n\tds_read_b64_tr_b16 %2, %18 offset:%32\n\tds_read_b64_tr_b16 %3, %19 offset:%32\n\t"
                 "ds_read_b64_tr_b16 %4, %20 offset:%32\n\tds_read_b64_tr_b16 %5, %21 offset:%32\n\tds_read_b64_tr_b16 %6, %22 offset:%32\n\tds_read_b64_tr_b16 %7, %23 offset:%32\n\t"
                 "ds_read_b64_tr_b16 %8, %24 offset:%32\n\tds_read_b64_tr_b16 %9, %25 offset:%32\n\tds_read_b64_tr_b16 %10, %26 offset:%32\n\tds_read_b64_tr_b16 %11, %27 offset:%32\n\t"
                 "ds_read_b64_tr_b16 %12, %28 offset:%32\n\tds_read_b64_tr_b16 %13, %29 offset:%32\n\tds_read_b64_tr_b16 %14, %30 offset:%32\n\tds_read_b64_tr_b16 %15, %31 offset:%32\n\ts_waitcnt lgkmcnt(0)"
                 : "=&v"(r[0]), "=&v"(r[1]), "=&v"(r[2]), "=&v"(r[3]), "=&v"(r[4]), "=&v"(r[5]), "=&v"(r[6]), "=&v"(r[7]), "=&v"(r[8]), "=&v"(r[9]), "=&v"(r[10]), "=&v"(r[11]), "=&v"(r[12]), "=&v"(r[13]), "=&v"(r[14]), "=&v"(r[15])
                 : "v"(a[0][0]), "v"(a[0][1]), "v"(a[1][0]), "v"(a[1][1]), "v"(a[2][0]), "v"(a[2][1]), "v"(a[3][0]), "v"(a[3][1]), "v"(a[4][0]), "v"(a[4][1]), "v"(a[5][0]), "v"(a[5][1]), "v"(a[6][0]), "v"(a[6][1]), "v"(a[7][0]), "v"(a[7][1]), "i"(OFF)
                 : "memory");
#pragma unroll
    for (int c = 0; c < 8; ++c) { bf16x8 t; t[0] = r[2 * c][0]; t[1] = r[2 * c][1]; t[2] = r[2 * c][2]; t[3] = r[2 * c][3]; t[4] = r[2 * c + 1][0]; t[5] = r[2 * c + 1][1]; t[6] = r[2 * c + 1][2]; t[7] = r[2 * c + 1][3]; f[c] = t; }
}

__device__ __forceinline__ void p0_transpose_item(const float* W, int K, int N, bf16* WT, int k0, int n0, int drow0, LAS float* scr, int lane) {
#pragma unroll 8
    for (int i = 0; i < 32; ++i) { const int kk = 2 * i + (lane >> 5); scr[kk * 33 + (lane & 31)] = W[(size_t)(k0 + kk) * N + n0 + (lane & 31)]; }
    asm volatile("s_waitcnt lgkmcnt(0)" ::: "memory");
    const int c = lane & 7;
#pragma unroll
    for (int j = 0; j < 4; ++j) { const int n = (lane >> 3) + 8 * j; const LAS float* s = scr + (8 * c) * 33 + n;
        u32x4 o; o.x = cvt_pk_bf16(s[0 * 33], s[1 * 33]); o.y = cvt_pk_bf16(s[2 * 33], s[3 * 33]); o.z = cvt_pk_bf16(s[4 * 33], s[5 * 33]); o.w = cvt_pk_bf16(s[6 * 33], s[7 * 33]);
        *(u32x4*)(WT + (size_t)(drow0 + n) * K + k0 + 8 * c) = o; }
    asm volatile("s_waitcnt lgkmcnt(0)" ::: "memory");
}
constexpr int N8E = NE * ((D / 128) * (2 * DE / 32) + (DE / 128) * (D / 32));
constexpr int N8Q = N8E + (D / 128) * ((3 * AW + 2 * D) / 32);
constexpr int N8 = N8Q + (D / 128) * (D / 32);
struct P0Item { const float* src; unsigned char* dst; int N, K; float scale; };
__device__ __forceinline__ void p0_item8_decode(const Args& args, Frame& F, int it, P0Item& I) {
    constexpr int I_GU1 = (D / 128) * (2 * DE / 32);
    constexpr int I_D1 = (DE / 128) * (D / 32);
    if (it < NE * I_GU1) { const int e = it / I_GU1, q = it % I_GU1, nb = 2 * DE / 32, n0 = 32 * (q % nb), k0 = 128 * (q / nb);
        const int bj = n0 / DE, rem = n0 % DE, drow0 = 256 * (rem / 128) + 128 * bj + (rem % 128);
        I.src = ((const float*)args.in[14]) + (size_t)e * D * 2 * DE + (size_t)k0 * (2 * DE) + n0; I.dst = B_WGU8 + (size_t)e * 2 * DE * D + (size_t)drow0 * D + k0; I.N = 2 * DE; I.K = D; I.scale = pg8::SC_WGU; }
    else if (it < NE * (I_GU1 + I_D1)) { const int r = it - NE * I_GU1; const int e = r / I_D1, q = r % I_D1, nb = D / 32, n0 = 32 * (q % nb), k0 = 128 * (q / nb);
        I.src = ((const float*)args.in[16]) + (size_t)e * DE * D + (size_t)k0 * D + n0; I.dst = B_WD8 + (size_t)e * D * DE + (size_t)n0 * DE + k0; I.N = D; I.K = DE; I.scale = pg8::SC_WD; }
    else if (it >= N8Q) { const int q = it - N8Q, nb = D / 32, n0 = 32 * (q % nb), k0 = 128 * (q / nb);
        I.src = ((const float*)args.in[9]) + (size_t)k0 * D + n0; I.dst = B_WO8 + (size_t)n0 * D + k0; I.N = D; I.K = D; I.scale = pg8::SC_WO; }
    else { const int q = it - NE * (I_GU1 + I_D1), nb = (3 * AW + 2 * D) / 32, r0 = 32 * (q % nb), k0 = 128 * (q / nb);
        const int n0 = r0 < 3 * AW ? r0 : r0 + 2 * SW;
        I.src = ((const float*)args.in[2]) + (size_t)k0 * INW + n0; I.dst = B_WIN8 + (size_t)r0 * D + k0; I.N = INW; I.K = D; I.scale = pg8::SC_WGU; }
}
__device__ __forceinline__ void p0_item8_load(const P0Item& I, int lane, f32x4 (&v)[4][4]) {
    const int c = lane & 7, r = lane >> 3;
    const float* p = I.src + (size_t)(4 * r) * I.N + 4 * c;
#pragma unroll
    for (int j = 0; j < 4; ++j)
#pragma unroll
        for (int i = 0; i < 4; ++i) v[j][i] = __builtin_nontemporal_load((const f32x4*)(p + (size_t)(32 * j + i) * I.N));
}
__device__ __forceinline__ void p0_item8_store(const P0Item& I, int lane, const f32x4 (&v)[4][4], LAS unsigned* scr) {
    const int c = lane & 7, r = lane >> 3; const float s = I.scale;
#pragma unroll
    for (int j = 0; j < 4; ++j)
#pragma unroll
        for (int m = 0; m < 4; ++m) scr[(4 * c + m) * 33 + r + 8 * j] = pg8::pk4_fp8(v[j][0][m] * s, v[j][1][m] * s, v[j][2][m] * s, v[j][3][m] * s);
    asm volatile("s_waitcnt lgkmcnt(0)" ::: "memory");
    const int ch = lane & 7;
#pragma unroll
    for (int jj = 0; jj < 4; ++jj) { const int n = (lane >> 3) + 8 * jj; const LAS unsigned* q = scr + n * 33 + 4 * ch;
        u32x4 o; o.x = q[0]; o.y = q[1]; o.z = q[2]; o.w = q[3];
        *(u32x4*)(I.dst + (size_t)n * I.K + 16 * ch) = o; }
    asm volatile("s_waitcnt lgkmcnt(0)" ::: "memory");
}
#ifndef BG_NB
#define BG_NB 128
#endif
#ifndef BG_F0
#define BG_F0 0
#endif
constexpr int BG_N0 = (int)((long)N8E * BG_F0 / 1000);
__device__ __forceinline__ void p0_items8(const Args& args, Frame& F, int lo, int hi, int gw, int NGW) {
    LAS unsigned* scr8 = (LAS unsigned*)(F.lds + F.wave * 16384);
    f32x4 va[4][4], vb[4][4], vc[4][4]; P0Item Ia, Ib, Ic;
    int it = lo + gw;
    if (it < hi) { p0_item8_decode(args, F, it, Ia); p0_item8_load(Ia, F.lane, va); }
    if (it + NGW < hi) { p0_item8_decode(args, F, it + NGW, Ib); p0_item8_load(Ib, F.lane, vb); }
    while (it < hi) {
        if (it + 2 * NGW < hi) { p0_item8_decode(args, F, it + 2 * NGW, Ic); p0_item8_load(Ic, F.lane, vc); }
        p0_item8_store(Ia, F.lane, va, scr8);
        it += NGW; if (it >= hi) break;
        if (it + 2 * NGW < hi) { p0_item8_decode(args, F, it + 2 * NGW, Ia); p0_item8_load(Ia, F.lane, va); }
        p0_item8_store(Ib, F.lane, vb, scr8);
        it += NGW; if (it >= hi) break;
        if (it + 2 * NGW < hi) { p0_item8_decode(args, F, it + 2 * NGW, Ib); p0_item8_load(Ib, F.lane, vb); }
        p0_item8_store(Ic, F.lane, vc, scr8);
        it += NGW;
    }
}
__device__ __forceinline__ void p0_convert(const Args& args, Frame& F) {
    LAS float* scr = (LAS float*)(F.lds + F.wave * 16384);
    const int gw = F.bx * 8 + F.wave, NGW = F.G * 8;
    constexpr int I_IN = (D / 64) * (2 * SW / 32), I_A = (AO / 64) * (D / 32), I_B = (SW / 64) * (D / 32);
    constexpr int NITEMS = I_IN + I_A + I_B;
    for (int it = gw; it < NITEMS; it += NGW) {
        int r = it;
        if (r < I_IN) { const int nb = 2 * SW / 32; p0_transpose_item(((const float*)args.in[2]), D, INW, B_WIN, 64 * (r / nb), 3 * AW + 32 * (r % nb), 32 * (r % nb), scr, F.lane); continue; } r -= I_IN;
        if (r < I_A) { const int nb = D / 32; p0_transpose_item(((const float*)args.in[3]), AO, D, B_WA, 64 * (r / nb), 32 * (r % nb), 32 * (r % nb), scr, F.lane); continue; } r -= I_A;
        { const int nb = D / 32; p0_transpose_item(((const float*)args.in[8]), SW, D, B_WB, 64 * (r / nb), 32 * (r % nb), 32 * (r % nb), scr, F.lane); }
    }
    p0_items8(args, F, 0, BG_N0, gw, NGW);
    p0_items8(args, F, N8E, N8, gw, NGW);
    const size_t gt = (size_t)F.bx * 512 + F.tid, NT = (size_t)F.G * 512;
    for (size_t i0 = gt; i0 < (size_t)S * D / 8; i0 += 4 * NT) {
        f32x4 a[4], b[4];
#pragma unroll
        for (int u = 0; u < 4; ++u) { const size_t i = i0 + u * NT; if (i < (size_t)S * D / 8) { a[u] = __builtin_nontemporal_load(((const f32x4*)((const float*)args.in[0])) + 2 * i); b[u] = __builtin_nontemporal_load(((const f32x4*)((const float*)args.in[0])) + 2 * i + 1); } }
#pragma unroll
        for (int u = 0; u < 4; ++u) { const size_t i = i0 + u * NT; if (i < (size_t)S * D / 8) {
            u32x4 w; w.x = cvt_pk_bf16(a[u][0], a[u][1]); w.y = cvt_pk_bf16(a[u][2], a[u][3]); w.z = cvt_pk_bf16(b[u][0], b[u][1]); w.w = cvt_pk_bf16(b[u][2], b[u][3]); ((u32x4*)B_XB)[i] = w;
            u32x2 w8; w8.x = pg8::pk4_fp8(pg8::clamp448(a[u][0] * pg8::SC_X1), pg8::clamp448(a[u][1] * pg8::SC_X1), pg8::clamp448(a[u][2] * pg8::SC_X1), pg8::clamp448(a[u][3] * pg8::SC_X1));
            w8.y = pg8::pk4_fp8(pg8::clamp448(b[u][0] * pg8::SC_X1), pg8::clamp448(b[u][1] * pg8::SC_X1), pg8::clamp448(b[u][2] * pg8::SC_X1), pg8::clamp448(b[u][3] * pg8::SC_X1)); ((u32x2*)B_X8)[i] = w8; } }
    }
    for (size_t i = gt; i < (size_t)MAXROWS; i += NT) B_ROWTOK[i] = 0;
    for (size_t i = gt; i < (size_t)8 * 128 * 128 / 8; i += NT) { const f32x4 a = ((const f32x4*)((const float*)args.in[6]))[2 * i], b = ((const f32x4*)((const float*)args.in[6]))[2 * i + 1];
        u32x4 w; w.x = cvt_pk_bf16(a[0], a[1]); w.y = cvt_pk_bf16(a[2], a[3]); w.z = cvt_pk_bf16(b[0], b[1]); w.w = cvt_pk_bf16(b[2], b[3]); ((u32x4*)B_SGW)[i] = w; }
    for (size_t i = gt; i < (size_t)NE * D; i += NT) { const int e = (int)(i >> 11), k = (int)(i & 2047);
        ((_Float16*)B_WRT)[i] = (_Float16)((const float*)args.in[12])[(size_t)k * NE + e]; }
    for (size_t i = gt; i < (size_t)S * 16; i += NT) { const int t = (int)(i >> 4), j = (int)(i & 15);
        const float invf = (float)exp2(-(double)j * (18.931568569324174 / 16.0));
        const float ang = (float)((const int*)args.in[1])[t] * invf; float sn, cn; sincosf(ang, &sn, &cn);
        B_CS[2 * i] = cn; B_CS[2 * i + 1] = sn; }
}

struct AttnGeom { int g, h, dsh, L, r, b, hcol, sj0; };
__device__ __forceinline__ void attn_geom(int unit, AttnGeom& A) {
    A.g = unit / 512; A.h = (unit >> 7) & 3; const int blk = unit & 127;
    A.dsh = 2 * A.g; A.L = S >> A.dsh; const int bpr = A.L >> 7;
    A.r = blk / bpr; A.b = blk % bpr; A.hcol = A.g * 512 + A.h * 128; A.sj0 = A.b * 128 - 64;
}
__device__ __forceinline__ void attn_dma(Frame& F, const bf16* base, LAS unsigned char* img, const AttnGeom& A) {
#pragma unroll
    for (int ii = 0; ii < 8; ++ii) {
        const int i = F.wave + 8 * ii, j = 4 * i + (F.lane >> 4), cp = F.lane & 15, ch = cp ^ (((j & 3) << 2) | ((j >> 2) & 3));
        int sj = A.sj0 + j; sj = sj < 0 ? 0 : (sj > A.L - 1 ? A.L - 1 : sj);
        const size_t tok = ((size_t)sj << A.dsh) + A.r;
        __builtin_amdgcn_global_load_lds((const unsigned*)(base + tok * AW + A.hcol + 8 * ch), (LAS unsigned*)(img + i * 1024), 16, 0, 0);
    }
}
__device__ __forceinline__ void attn_phase(Frame& F) {
    LAS unsigned char* Kimg = F.lds;
    LAS unsigned char* Vimg = F.lds + 65536;
    int unit = F.c; if (unit >= 1536) return;
    AttnGeom A; attn_geom(unit, A);
    attn_dma(F, B_KB, Kimg, A); attn_dma(F, B_VB, Vimg, A);
    for (;;) {
        const int un = unit + F.GG; const bool hn = un < 1536; AttnGeom An = A; if (hn) attn_geom(un, An);
        const int g = A.g, h = A.h, dsh = A.dsh, L = A.L, r = A.r, b = A.b, hcol = A.hcol, sj0 = A.sj0;
        const int jmin = sj0 < 0 ? -sj0 : 0, jmax = (L - sj0) < 256 ? (L - sj0) : 256;
        const int w = F.wave, lane = F.lane, fr = lane & 15, fq = lane >> 4;
        const int iq = 16 * w + fr;
        const size_t tq = ((size_t)(b * 128 + iq) << dsh) + r;
        bf16x8 Qf[4];
#pragma unroll
        for (int ks = 0; ks < 4; ++ks) Qf[ks] = *(const bf16x8*)(B_QB + tq * AW + hcol + 32 * ks + 8 * fq);
        asm volatile("s_waitcnt vmcnt(0)" ::: "memory"); __builtin_amdgcn_s_barrier(); asm volatile("" ::: "memory");
        const int sb0 = w >> 1;
        f32x4 Sx[5][2];
        const int krow = 8 * (fr >> 2) + (fr & 3);
        const LAS unsigned char* Kw = Kimg + sb0 * 8192;
        unsigned kaddr[2][4];
#pragma unroll
        for (int hf = 0; hf < 2; ++hf)
#pragma unroll
            for (int ks = 0; ks < 4; ++ks) kaddr[hf][ks] = off_b(krow + 4 * hf, 4 * ks + fq);
#pragma unroll
        for (int sbi = 0; sbi < 5; ++sbi)
#pragma unroll
            for (int hf = 0; hf < 2; ++hf) {
                f32x4 a = (f32x4){0.f, 0.f, 0.f, 0.f};
#pragma unroll
                for (int ks = 0; ks < 4; ++ks) {
                    const bf16x8 kf = *(const LAS bf16x8*)(Kw + kaddr[hf][ks] + sbi * 8192);
                    a = __builtin_amdgcn_mfma_f32_16x16x32_bf16(kf, Qf[ks], a, 0, 0, 0);
                }
                Sx[sbi][hf] = a;
            }
        asm volatile("s_waitcnt lgkmcnt(0)" ::: "memory"); __builtin_amdgcn_s_barrier(); asm volatile("" ::: "memory");
        if (hn) attn_dma(F, B_KB, Kimg, An);
        const float sc = 0.08838834764831845f;
        float mx = -3.0e38f;
#pragma unroll
        for (int sbi = 0; sbi < 5; ++sbi)
#pragma unroll
            for (int hf = 0; hf < 2; ++hf)
#pragma unroll
                for (int j = 0; j < 4; ++j) {
                    const int kj = 32 * (sb0 + sbi) + 8 * fq + 4 * hf + j;
                    const bool ok = (kj >= iq) && (kj <= iq + 128) && (kj >= jmin) && (kj < jmax);
                    const float s = ok ? Sx[sbi][hf][j] * sc : -1.0e30f;
                    Sx[sbi][hf][j] = s; mx = fmaxf(mx, s);
                }
        mx = fmaxf(mx, __shfl_xor(mx, 16)); mx = fmaxf(mx, __shfl_xor(mx, 32));
        float den = 0.f;
#pragma unroll
        for (int sbi = 0; sbi < 5; ++sbi)
#pragma unroll
            for (int hf = 0; hf < 2; ++hf)
#pragma unroll
                for (int j = 0; j < 4; ++j) { const float p = fast_exp2((Sx[sbi][hf][j] - mx) * 1.44269504089f); Sx[sbi][hf][j] = p; den += p; }
        den += __shfl_xor(den, 16); den += __shfl_xor(den, 32);
        bf16x8 Pf[5];
#pragma unroll
        for (int sbi = 0; sbi < 5; ++sbi) {
            u32x4 w4; w4.x = cvt_pk_bf16(Sx[sbi][0][0], Sx[sbi][0][1]); w4.y = cvt_pk_bf16(Sx[sbi][0][2], Sx[sbi][0][3]);
            w4.z = cvt_pk_bf16(Sx[sbi][1][0], Sx[sbi][1][1]); w4.w = cvt_pk_bf16(Sx[sbi][1][2], Sx[sbi][1][3]);
            Pf[sbi] = __builtin_bit_cast(bf16x8, w4);
        }
        f32x4 O[8];
#pragma unroll
        for (int c = 0; c < 8; ++c) O[c] = (f32x4){0.f, 0.f, 0.f, 0.f};
        const unsigned vbase = (unsigned)(size_t)Vimg + (unsigned)sb0 * 8192u;
        unsigned vaddr[8][2];
#pragma unroll
        for (int c = 0; c < 8; ++c) { vaddr[c][0] = vbase + tr_addr16(lane, c, 0, 0); vaddr[c][1] = vbase + tr_addr16(lane, c, 0, 1); }
#define PV_STEP(sbi) do { bf16x8 vf[8]; tr_read16<(sbi) * 8192>(vaddr, vf); _Pragma("unroll") for (int c = 0; c < 8; ++c) \
            O[c] = __builtin_amdgcn_mfma_f32_16x16x32_bf16(vf[c], Pf[sbi], O[c], 0, 0, 0); } while (0)
        PV_STEP(0); PV_STEP(1); PV_STEP(2); PV_STEP(3); PV_STEP(4);
#undef PV_STEP
        const float rden = 1.0f / den;
        bf16* op = B_OG + ((size_t)g * S + tq) * AO + h * 128 + 4 * fq;
#pragma unroll
        for (int c = 0; c < 8; ++c) { const f32x4 o = O[c] * rden; u32x2 w2; w2.x = cvt_pk_bf16(o[0], o[1]); w2.y = cvt_pk_bf16(o[2], o[3]); *(u32x2*)(op + 16 * c) = w2; }
        asm volatile("s_waitcnt lgkmcnt(0)" ::: "memory"); __builtin_amdgcn_s_barrier(); asm volatile("" ::: "memory");
        if (hn) attn_dma(F, B_VB, Vimg, An);
        if (fq == 0) B_LSE[((size_t)g * S + tq) * 4 + h] = mx + __logf(den);
        if (!hn) break;
        unit = un; A = An;
    }
    asm volatile("s_waitcnt vmcnt(0)" ::: "memory"); __syncthreads();
}
__device__ __forceinline__ void sgu_stats(Frame& F) {
    const int gw = F.c * 8 + F.wave, NGW = F.GG * 8;
    for (int tb = gw; tb < S; tb += 4 * NGW) {
        u32x4 a[4], b[4];
#pragma unroll
        for (int i = 0; i < 4; ++i) { const int t = tb + i * NGW; const u32x4* p = (const u32x4*)(B_ZB + (size_t)(t < S ? t : 0) * 2048 + SW + 16 * F.lane); a[i] = p[0]; b[i] = p[1]; }
#pragma unroll
        for (int i = 0; i < 4; ++i) {
            const int t = tb + i * NGW;
            float v[16] = {bflo(a[i].x), bfhi(a[i].x), bflo(a[i].y), bfhi(a[i].y), bflo(a[i].z), bfhi(a[i].z), bflo(a[i].w), bfhi(a[i].w), bflo(b[i].x), bfhi(b[i].x), bflo(b[i].y), bfhi(b[i].y), bflo(b[i].z), bfhi(b[i].z), bflo(b[i].w), bfhi(b[i].w)};
            float s = 0.f;
#pragma unroll
            for (int k = 0; k < 16; ++k) s += v[k];
            const float mean = wave_sum(s) * (1.0f / SW);
            float q = 0.f;
#pragma unroll
            for (int k = 0; k < 16; ++k) { const float d = v[k] - mean; q += d * d; }
            const float rstd = 1.0f / sqrtf(wave_sum(q) * (1.0f / SW) + LN_EPS);
            if (F.lane == 0 && t < S) { B_VST[2 * t] = mean; B_VST[2 * t + 1] = rstd; }
        }
    }
}
__device__ __forceinline__ void sgu_unit(const Args& args, Frame& F, int unit) {
    const int c = unit >> 3, g = unit & 7, t0 = 128 * c;
    const int w = F.wave, lane = F.lane, fr = lane & 15, fq = lane >> 4;
    LAS unsigned char* Vimg = F.lds;
#pragma unroll
    for (int i = 0; i < 4; ++i) {
        const int q = F.tid + 512 * i, s = q >> 4, ch = q & 15;
        const u32x4 a = *(const u32x4*)(B_ZB + (size_t)(t0 + s) * 2048 + SW + 128 * g + 8 * ch);
        const f32x2 ms = *(const f32x2*)(B_VST + 2 * (t0 + s)); const float mean = ms.x, rstd = ms.y;
        const float* gp = ((const float*)args.in[4]) + 128 * g + 8 * ch; const float* bp = ((const float*)args.in[5]) + 128 * g + 8 * ch;
        const f32x4 g0 = *(const f32x4*)gp, g1 = *(const f32x4*)(gp + 4), b0 = *(const f32x4*)bp, b1 = *(const f32x4*)(bp + 4);
        float v[8] = {bflo(a.x), bfhi(a.x), bflo(a.y), bfhi(a.y), bflo(a.z), bfhi(a.z), bflo(a.w), bfhi(a.w)};
#pragma unroll
        for (int e = 0; e < 8; ++e) v[e] = (v[e] - mean) * rstd * (e < 4 ? g0[e & 3] : g1[e & 3]) + (e < 4 ? b0[e & 3] : b1[e & 3]);
        u32x4 o; o.x = cvt_pk_bf16(v[0], v[1]); o.y = cvt_pk_bf16(v[2], v[3]); o.z = cvt_pk_bf16(v[4], v[5]); o.w = cvt_pk_bf16(v[6], v[7]);
        *(LAS u32x4*)(Vimg + off_b(s, ch)) = o;
    }
    bf16x8 Wf[4];
#pragma unroll
    for (int ks = 0; ks < 4; ++ks) Wf[ks] = *(const bf16x8*)(B_SGW + ((size_t)(g * 128 + 16 * w + fr)) * 128 + 32 * ks + 8 * fq);
    __syncthreads();
    const unsigned vbase = (unsigned)(size_t)Vimg;
    const int t = t0 + 16 * w + fr;
    const float bias = ((const float*)args.in[7])[g * 128 + 16 * w + fr];
#pragma unroll
    for (int cb = 0; cb < 8; ++cb) {
        f32x4 a = (f32x4){0.f, 0.f, 0.f, 0.f};
        const unsigned a0 = vbase + tr_addr16(lane, cb, 0, 0), a1 = vbase + tr_addr16(lane, cb, 0, 1);
        a = __builtin_amdgcn_mfma_f32_16x16x32_bf16(tr_read2<0>(a0, a1), Wf[0], a, 0, 0, 0);
        a = __builtin_amdgcn_mfma_f32_16x16x32_bf16(tr_read2<8192>(a0, a1), Wf[1], a, 0, 0, 0);
        a = __builtin_amdgcn_mfma_f32_16x16x32_bf16(tr_read2<16384>(a0, a1), Wf[2], a, 0, 0, 0);
        a = __builtin_amdgcn_mfma_f32_16x16x32_bf16(tr_read2<24576>(a0, a1), Wf[3], a, 0, 0, 0);
        const int chn = 128 * g + 16 * cb + 4 * fq;
        const u32x2 uu = *(const u32x2*)(B_ZB + (size_t)t * 2048 + chn);
        u32x2 o; o.x = cvt_pk_bf16(bflo(uu.x) * (a[0] + bias), bfhi(uu.x) * (a[1] + bias)); o.y = cvt_pk_bf16(bflo(uu.y) * (a[2] + bias), bfhi(uu.y) * (a[3] + bias));
        *(u32x2*)(B_SGI + (size_t)t * SW + chn) = o;
    }
    __syncthreads();
}

__device__ __forceinline__ void p3_combine(Frame& F) {
    const size_t gt = (size_t)F.c * 512 + F.tid, NT = (size_t)F.GG * 512;
    for (size_t i = gt; i < (size_t)S * AO / 8; i += NT) {
        const int t = (int)(i >> 6), c8 = (int)(i & 63), h = c8 >> 4;
        const float l0 = B_LSE[((size_t)0 * S + t) * 4 + h], l1 = B_LSE[((size_t)1 * S + t) * 4 + h], l2 = B_LSE[((size_t)2 * S + t) * 4 + h];
        const float m = fmaxf(l0, fmaxf(l1, l2));
        float w0 = __expf(l0 - m), w1 = __expf(l1 - m), w2 = __expf(l2 - m); const float rs = 1.0f / (w0 + w1 + w2); w0 *= rs; w1 *= rs; w2 *= rs;
        const u32x4 q0 = *(const u32x4*)(B_OG + ((size_t)0 * S + t) * AO + 8 * c8), q1 = *(const u32x4*)(B_OG + ((size_t)1 * S + t) * AO + 8 * c8), q2 = *(const u32x4*)(B_OG + ((size_t)2 * S + t) * AO + 8 * c8);
        const f32x4 a = (f32x4){bflo(q0.x), bfhi(q0.x), bflo(q0.y), bfhi(q0.y)} * w0 + (f32x4){bflo(q1.x), bfhi(q1.x), bflo(q1.y), bfhi(q1.y)} * w1 + (f32x4){bflo(q2.x), bfhi(q2.x), bflo(q2.y), bfhi(q2.y)} * w2;
        const f32x4 b = (f32x4){bflo(q0.z), bfhi(q0.z), bflo(q0.w), bfhi(q0.w)} * w0 + (f32x4){bflo(q1.z), bfhi(q1.z), bflo(q1.w), bfhi(q1.w)} * w1 + (f32x4){bflo(q2.z), bfhi(q2.z), bflo(q2.w), bfhi(q2.w)} * w2;
        u32x4 o; o.x = cvt_pk_bf16(a[0], a[1]); o.y = cvt_pk_bf16(a[2], a[3]); o.z = cvt_pk_bf16(b[0], b[1]); o.w = cvt_pk_bf16(b[2], b[3]);
        ((u32x4*)B_OA)[i] = o;
    }
}

__device__ __forceinline__ void p6_ln_router(const Args& args, Frame& F) {
    LAS float* xl = (LAS float*)F.lds;
    LAS float* part = (LAS float*)(F.lds + LDS_PART);
    LAS float* lg = (LAS float*)(F.lds + LDS_MISC + MISC_LG);
    LAS float* sel = lg + 512;
    LAS int* lcnt = (LAS int*)(F.lds + LDS_MISC + MISC_LC);
    const int fr = F.lane & 15, fq = F.lane >> 4;
    if (F.tid < 32) lcnt[F.tid] = 0;
    __syncthreads();
    h16x8 Bw[8][2];
    {   const _Float16* wh = (const _Float16*)B_WRT + (size_t)fr * D + 256 * F.wave + 8 * fq;
#pragma unroll
        for (int ks = 0; ks < 8; ++ks)
#pragma unroll
            for (int nb = 0; nb < 2; ++nb) Bw[ks][nb] = *(const h16x8*)(wh + (size_t)(16 * nb) * D + 32 * ks); }
    const float brt = ((const float*)args.in[13])[F.tid & 31];
    u32x4 raw[2][4];
    int it = F.c;
    if (it < S / 16) {
#pragma unroll
        for (int rr = 0; rr < 2; ++rr) { const u32x4* xp = (const u32x4*)(B_X1F + (size_t)(16 * it + 2 * F.wave + rr) * D) + F.lane;
#pragma unroll
            for (int j = 0; j < 4; ++j) raw[rr][j] = xp[64 * j]; }
    }
    for (; it < S / 16; it += F.GG) {
        const int t0 = 16 * it;
#pragma unroll
        for (int rr = 0; rr < 2; ++rr) {
            const int rl = 2 * F.wave + rr; const size_t row = (size_t)(t0 + rl);
            f32x4 v[4][2];
#pragma unroll
            for (int j = 0; j < 4; ++j) { const u32x4 r4 = raw[rr][j]; v[j][0] = (f32x4){bflo(r4.x), bfhi(r4.x), bflo(r4.y), bfhi(r4.y)}; v[j][1] = (f32x4){bflo(r4.z), bfhi(r4.z), bflo(r4.w), bfhi(r4.w)}; }
            float s = 0.f;
#pragma unroll
            for (int j = 0; j < 4; ++j)
#pragma unroll
                for (int hh = 0; hh < 2; ++hh) s += (v[j][hh][0] + v[j][hh][1]) + (v[j][hh][2] + v[j][hh][3]);
            const float mean = wave_sum(s) * (1.0f / D); float q = 0.f;
#pragma unroll
            for (int j = 0; j < 4; ++j)
#pragma unroll
                for (int hh = 0; hh < 2; ++hh) { v[j][hh] = v[j][hh] - mean; q += (v[j][hh][0] * v[j][hh][0] + v[j][hh][1] * v[j][hh][1]) + (v[j][hh][2] * v[j][hh][2] + v[j][hh][3] * v[j][hh][3]); }
            const float rstd = 1.0f / sqrtf(wave_sum(q) * (1.0f / D) + LN_EPS);
            if (F.lane == 0) *(f32x2*)(B_LN1ST + 2 * row) = (f32x2){mean, rstd};
#pragma unroll
            for (int j = 0; j < 4; ++j) {
                const int col = 8 * F.lane + 512 * j;
                const float* gp = ((const float*)args.in[10]) + col; const float* bp = ((const float*)args.in[11]) + col;
                const f32x4 y0 = v[j][0] * rstd * *(const f32x4*)gp + *(const f32x4*)bp, y1 = v[j][1] * rstd * *(const f32x4*)(gp + 4) + *(const f32x4*)(bp + 4);
                { u32x2 x8; x8.x = pg8::pk4_fp8(pg8::clamp448(y0[0] * pg8::SC_X1), pg8::clamp448(y0[1] * pg8::SC_X1), pg8::clamp448(y0[2] * pg8::SC_X1), pg8::clamp448(y0[3] * pg8::SC_X1));
                  x8.y = pg8::pk4_fp8(pg8::clamp448(y1[0] * pg8::SC_X1), pg8::clamp448(y1[1] * pg8::SC_X1), pg8::clamp448(y1[2] * pg8::SC_X1), pg8::clamp448(y1[3] * pg8::SC_X1));
                  *(u32x2*)(B_X1Q + row * D + col) = x8; }
                *(LAS f32x4*)(xl + rl * XLP + col) = y0; *(LAS f32x4*)(xl + rl * XLP + col + 4) = y1;
            }
        }
        __syncthreads();
        {
            f32x4 acc[2] = {(f32x4){0.f, 0.f, 0.f, 0.f}, (f32x4){0.f, 0.f, 0.f, 0.f}};
            const LAS float* xr = xl + fr * XLP + 256 * F.wave + 8 * fq;
#pragma unroll
            for (int ks = 0; ks < 8; ++ks) {
                const f32x4 a0 = *(const LAS f32x4*)(xr + 32 * ks), a1 = *(const LAS f32x4*)(xr + 32 * ks + 4);
                u32x4 hw;
                hw.x = __builtin_bit_cast(unsigned, __builtin_amdgcn_cvt_pkrtz(a0[0], a0[1])); hw.y = __builtin_bit_cast(unsigned, __builtin_amdgcn_cvt_pkrtz(a0[2], a0[3]));
                hw.z = __builtin_bit_cast(unsigned, __builtin_amdgcn_cvt_pkrtz(a1[0], a1[1])); hw.w = __builtin_bit_cast(unsigned, __builtin_amdgcn_cvt_pkrtz(a1[2], a1[3]));
                const h16x8 Ah = __builtin_bit_cast(h16x8, hw);
#pragma unroll
                for (int nb = 0; nb < 2; ++nb) acc[nb] = __builtin_amdgcn_mfma_f32_16x16x32_f16(Ah, Bw[ks][nb], acc[nb], 0, 0, 0);
            }
#pragma unroll
            for (int nb = 0; nb < 2; ++nb)
#pragma unroll
                for (int j = 0; j < 4; ++j) part[(F.wave * 16 + 4 * fq + j) * 32 + 16 * nb + fr] = acc[nb][j];
        }
        {   const int itn = it + F.GG;
            if (itn < S / 16) {
#pragma unroll
                for (int rr = 0; rr < 2; ++rr) { const u32x4* xp = (const u32x4*)(B_X1F + (size_t)(16 * itn + 2 * F.wave + rr) * D) + F.lane;
#pragma unroll
                    for (int j = 0; j < 4; ++j) raw[rr][j] = xp[64 * j]; }
            } }
        __syncthreads();
        {
            const int tl = F.tid >> 5, e = F.tid & 31, t = t0 + tl; float lgt = brt;
#pragma unroll
            for (int w8 = 0; w8 < 8; ++w8) lgt += part[(w8 * 16 + tl) * 32 + e];
            lg[tl * 32 + e] = lgt;
            asm volatile("s_waitcnt lgkmcnt(0)" ::: "memory");
            int rank = 0;
#pragma unroll
            for (int q4 = 0; q4 < 8; ++q4) { const f32x4 o = *(const LAS f32x4*)(lg + tl * 32 + 4 * q4);
#pragma unroll
                for (int j = 0; j < 4; ++j) { const int e2 = 4 * q4 + j; rank += (o[j] > lgt || (o[j] == lgt && e2 < e)) ? 1 : 0; } }
            if (rank < 4) sel[tl * 4 + rank] = lgt;
            asm volatile("s_waitcnt lgkmcnt(0)" ::: "memory");
            if (rank < 4) {
                const f32x4 sv = *(const LAS f32x4*)(sel + tl * 4);
                const float den = 1.0f + __expf(sv[1] - sv[0]) + __expf(sv[2] - sv[0]) + __expf(sv[3] - sv[0]);
                const int lrank = __hip_atomic_fetch_add(lcnt + e, 1, __ATOMIC_RELAXED, __HIP_MEMORY_SCOPE_WORKGROUP);
                B_TGATE[t * 4 + rank] = __expf(lgt - sv[0]) / den;
                B_INV[t * 4 + rank] = (e << 16) | lrank;
            }
        }
        __syncthreads();
    }
    if (F.tid < 32) B_CNTWG[F.c * 32 + F.tid] = lcnt[F.tid];
}
__device__ __forceinline__ void compute_tp(Frame& F) {
    LAS int* tp = (LAS int*)(F.lds + LDS_MISC + MISC_TP); LAS int* cnt = (LAS int*)(F.lds + LDS_MISC + MISC_CNT); LAS int* base = (LAS int*)(F.lds + LDS_MISC + MISC_BASE);
    LAS int* part = (LAS int*)(F.lds + LDS_MISC + MISC_PART);
    {   const int e = F.tid & 31, p = F.tid >> 5, per = (F.GG + 15) >> 4; int tot = 0, pre = 0;
        for (int i = 0; i < per; ++i) { const int wg = p * per + i; if (wg < F.GG) { const int c = B_CNTWG[wg * 32 + e]; tot += c; pre += (wg < F.c) ? c : 0; } }
        part[p * 32 + e] = tot; part[512 + p * 32 + e] = pre; }
    __syncthreads();
    if (F.tid < 32) { int tot = 0, pre = 0;
#pragma unroll
        for (int p = 0; p < 16; ++p) { tot += part[p * 32 + F.tid]; pre += part[512 + p * 32 + F.tid]; }
        cnt[F.tid] = tot; base[F.tid] = pre; }
    __syncthreads();
    if (F.tid == 0) { int acc = 0; tp[0] = 0; for (int e = 0; e < NE; ++e) { acc += (cnt[e] + 255) >> 8; tp[e + 1] = acc; } }
    __syncthreads();
}
__device__ __forceinline__ void load_tp(Frame& F) {
    LAS int* tp = (LAS int*)(F.lds + LDS_MISC + MISC_TP); LAS int* cnt = (LAS int*)(F.lds + LDS_MISC + MISC_CNT);
    if (F.tid < 33) tp[F.tid] = B_TPG[F.tid];
    if (F.tid >= 64 && F.tid < 96) cnt[F.tid - 64] = B_TPG[33 + F.tid - 64];
    __syncthreads();
}
__device__ __forceinline__ void p7_scatter(Frame& F) {
    const LAS int* tp = (const LAS int*)(F.lds + LDS_MISC + MISC_TP); const LAS int* base = (const LAS int*)(F.lds + LDS_MISC + MISC_BASE);
    for (int q = F.tid; ; q += 512) {
        const int it = F.c + (q >> 6) * F.GG; if (it >= S / 16) break;
        const int i = (16 * it) * 4 + (q & 63), es = B_INV[i], e = es >> 16;
        const int R = 256 * tp[e] + base[e] + (es & 0xffff);
        B_ROWTOK[R] = i >> 2; B_RGATE[R] = B_TGATE[i]; B_INV[i] = R;
    }
}
__device__ __forceinline__ f32x4 fp8x4_to_f32(unsigned w) { const f32x2 lo = __builtin_amdgcn_cvt_pk_f32_fp8((int)w, false), hi = __builtin_amdgcn_cvt_pk_f32_fp8((int)w, true); return (f32x4){lo.x, lo.y, hi.x, hi.y}; }
__device__ __forceinline__ void p10_final(const Args& args, Frame& F) {
    const int gw = F.c * 8 + F.wave, NGW = F.GG * 8;
    int Rn[4] = {0, 0, 0, 0};
    u32x4 ya[2][4], xh[2][2]; f32x2 st1 = (f32x2){0.f, 1.f};
    LAS float* gl = (LAS float*)F.lds; LAS float* bl = gl + D; LAS float* g2l = bl + D; LAS float* b2l = g2l + D;
    for (int i = F.tid; i < D; i += 512) { gl[i] = ((const float*)args.in[10])[i]; bl[i] = ALPHA * ((const float*)args.in[11])[i]; g2l[i] = ((const float*)args.in[18])[i]; b2l[i] = ((const float*)args.in[19])[i]; }
    __syncthreads();
#define P10_ROWS(tt) do { _Pragma("unroll") for (int k = 0; k < 4; ++k) Rn[k] = B_INV[(tt) * 4 + k]; } while (0)
#define P10_LOAD(tt) do { const u32x4* xp_ = (const u32x4*)(B_X1F + (size_t)(tt) * D) + 2 * F.lane; st1 = *(const f32x2*)(B_LN1ST + 2 * (size_t)(tt)); \
        _Pragma("unroll") for (int j = 0; j < 2; ++j) { _Pragma("unroll") for (int k = 0; k < 4; ++k) ya[j][k] = *(const u32x4*)(B_YB + (size_t)Rn[k] * D + 16 * F.lane + 1024 * j); \
            xh[j][0] = xp_[128 * j]; xh[j][1] = xp_[128 * j + 1]; } } while (0)
    if (gw < S) { P10_ROWS(gw); P10_LOAD(gw); if (gw + NGW < S) P10_ROWS(gw + NGW); }
    for (int t = gw; t < S; t += NGW) {
        f32x4 v[8]; float s = 0.f;
        const float a1 = ALPHA * st1.y, c1 = -st1.x * a1;
        int lo16 = 16 * F.lane; asm volatile("" : "+v"(lo16));
#pragma unroll
        for (int j = 0; j < 2; ++j) {
            const LAS float* gq = gl + lo16 + 1024 * j; const LAS float* bq = bl + lo16 + 1024 * j;
            f32x4 ys[4];
#pragma unroll
            for (int w = 0; w < 4; ++w) ys[w] = (f32x4){0.f, 0.f, 0.f, 0.f};
#pragma unroll
            for (int k = 0; k < 4; ++k) { const u32x4 a = ya[j][k]; ys[0] += fp8x4_to_f32(a.x); ys[1] += fp8x4_to_f32(a.y); ys[2] += fp8x4_to_f32(a.z); ys[3] += fp8x4_to_f32(a.w); }
            const u32x4 x0 = xh[j][0], x1 = xh[j][1];
            const f32x4 xr[4] = {(f32x4){bflo(x0.x), bfhi(x0.x), bflo(x0.y), bfhi(x0.y)}, (f32x4){bflo(x0.z), bfhi(x0.z), bflo(x0.w), bfhi(x0.w)},
                                 (f32x4){bflo(x1.x), bfhi(x1.x), bflo(x1.y), bfhi(x1.y)}, (f32x4){bflo(x1.z), bfhi(x1.z), bflo(x1.w), bfhi(x1.w)}};
#pragma unroll
            for (int w = 0; w < 4; ++w) {
                const f32x4 vv = (xr[w] * a1 + c1) * *(const LAS f32x4*)(gq + 4 * w) + (*(const LAS f32x4*)(bq + 4 * w) + ys[w] * (1.0f / pg8::SC_Y));
                v[4 * j + w] = vv; s += (vv[0] + vv[1]) + (vv[2] + vv[3]); }
        }
        if (t + NGW < S) { P10_LOAD(t + NGW); if (t + 2 * NGW < S) P10_ROWS(t + 2 * NGW); }
        const float mean = wave_sum(s) * (1.0f / D); float q = 0.f;
#pragma unroll
        for (int j = 0; j < 8; ++j) { v[j] = v[j] - mean; q += (v[j][0] * v[j][0] + v[j][1] * v[j][1]) + (v[j][2] * v[j][2] + v[j][3] * v[j][3]); }
        const float rstd = 1.0f / sqrtf(wave_sum(q) * (1.0f / D) + LN_EPS);
        float* op = args.out + (size_t)t * D;
#pragma unroll
        for (int j = 0; j < 2; ++j)
#pragma unroll
            for (int w = 0; w < 4; ++w) { const int col = 16 * F.lane + 1024 * j + 4 * w, lc = lo16 + 1024 * j + 4 * w;
                *(f32x4*)(op + col) = v[4 * j + w] * rstd * *(const LAS f32x4*)(g2l + lc) + *(const LAS f32x4*)(b2l + lc); }
    }
#undef P10_ROWS
#undef P10_LOAD
}

constexpr int N_PHASES = 11;
__global__ void __launch_bounds__(512, 2) mk_fwd(Args args) {
    extern __shared__ __attribute__((aligned(16))) unsigned char lds_raw[];
    Frame F;
    F.lds = (LAS unsigned char*)lds_raw;
    const int tid0 = threadIdx.x;
    F.tid = tid0; F.lane = tid0 & 63; F.wave = __builtin_amdgcn_readfirstlane(tid0 >> 6); F.G = gridDim.x; F.bx = blockIdx.x; F.c = F.bx; F.GG = F.G;
    unsigned char* ws = args.ws;
    F.ws = ws; F.ctl = (unsigned*)(ws + WS_CTL);
    for (int u = tid0; u < (LDS_BYTES - LDS_MISC) / 4; u += 512) ((LAS unsigned*)(F.lds + LDS_MISC))[u] = 0u;
    __syncthreads();
    const int lo = args.ph_lo, hi = args.ph_hi;
    const bool one = (hi - lo) > 1;
    XcdBarrier bar; bar.bar = F.ctl + CW_BAR; bar.x = 0; bar.st = (volatile LAS unsigned*)(F.lds + LDS_MISC + MISC_BAR);
    if (one) bar = xcd_barrier_post(F.ctl + CW_BAR, (volatile LAS unsigned*)(F.lds + LDS_MISC + MISC_BAR), tid0 == 0);
#ifndef PH_MASK
#define PH_MASK 0x7ff
#endif
#define IN(k) (((PH_MASK >> (k)) & 1) && lo <= (k) && (k) < hi)
#define SEAM(k) do { if (IN(k) && IN((k) + 1)) xcd_barrier(bar, F.wave == 0 && hw_lane() == 0); } while (0)
#define RELANE() do { F.lane = hw_lane(); F.tid = F.wave * 64 + F.lane; } while (0)
    const LAS int* tp = (const LAS int*)(F.lds + LDS_MISC + MISC_TP);

    const int GF = F.G - BG_NB; const bool bgw = (BG_NB > 0) && (F.bx >= GF);
    const int bgi = (F.bx - GF) * 8 + F.wave, bgn = BG_NB * 8;
    if (IN(0)) { RELANE(); p0_convert(args, F); }
    SEAM(0);
    if (IN(1)) { RELANE();
        if (bgw) { p0_items8(args, F, BG_N0, N8E, bgi, bgn); __syncthreads(); }
        { pg8::QueueOrder So; So.init(B_X8, B_WIN8, S, 3 * AW + 2 * D, D, F.ctl + CW_Q1, (volatile LAS unsigned*)(F.lds + LDS_MISC + MISC_QS), (int)xb_xcc_id(), F.wave);
          pg8::EpiIn E{B_QB, B_KB, B_VB, B_ZB, B_GT, B_CS, 0, 1.0f / (pg8::SC_X1 * pg8::SC_WGU)};
          pg8::gemm_phase<pg8::EpiIn, pg8::QueueOrder, true>(F.lds, D, So, E, F.wave); }
        { pg8::DenseOrder So; So.init(B_XB, B_WIN, S, 2 * SW, 2 * D, F.G, F.G - 1 - F.bx);
          pg8::EpiIn E{B_QB, B_KB, B_VB, B_ZB, B_GT, B_CS, 18, 1.0f};
          pg8::gemm_phase<pg8::EpiIn, pg8::DenseOrder>(F.lds, 2 * D, So, E, F.wave); }
    }
    SEAM(1);
    if (IN(2)) { RELANE(); attn_phase(F); sgu_stats(F); }
    SEAM(2);
    if (IN(3)) { RELANE(); for (int u = F.c; u < 1024; u += F.GG) sgu_unit(args, F, u); p3_combine(F); }
    SEAM(3);
    if (IN(4)) { RELANE();
        { pg8::DenseOrder So; So.init(B_OA, B_WA, S, D, 2 * AO, F.G, F.bx); pg8::EpiGateT<false> E{B_MRG, B_GT, 0, 0, nullptr};
          pg8::gemm_phase<pg8::EpiGateT<false>, pg8::DenseOrder>(F.lds, 2 * AO, So, E, F.wave); }
        { pg8::DenseOrder So; So.init(B_SGI, B_WB, S, D, 2 * SW, F.G, F.bx); pg8::EpiGateT<true> E{B_MRG, B_GT, 2048, 1, B_MRG8};
          pg8::gemm_phase<pg8::EpiGateT<true>, pg8::DenseOrder>(F.lds, 2 * SW, So, E, F.wave); }
    }
    SEAM(4);
    if (IN(5)) { RELANE(); pg8::DenseOrder So; So.init(B_MRG8, B_WO8, S, D, D, F.G, F.bx); pg8::EpiX1 E{B_XB, B_X1F, 1.0f / (pg8::SC_MRG * pg8::SC_WO)};
        pg8::gemm_phase<pg8::EpiX1, pg8::DenseOrder, true>(F.lds, D, So, E, F.wave); }
    SEAM(5);
    if (IN(6)) { RELANE(); p6_ln_router(args, F); }
    SEAM(6);
    if (IN(7)) { RELANE(); compute_tp(F); if (F.bx == 0) { if (F.tid < 33) B_TPG[F.tid] = tp[F.tid]; if (F.tid >= 64 && F.tid < 96) B_TPG[33 + F.tid - 64] = ((const LAS int*)(F.lds + LDS_MISC + MISC_CNT))[F.tid - 64]; } p7_scatter(F); }
    SEAM(7);
    if (IN(8)) { RELANE(); load_tp(F); pg8::MoeOrder So; So.init(B_X1Q, B_WGU8, tp, __builtin_amdgcn_readfirstlane(tp[32]), 2 * DE, D, F.G, F.bx); pg8::EpiSwiglu8 E{B_HB8, ((const float*)args.in[15])};
        So.rowtok = B_ROWTOK; So.ids = (LAS unsigned*)(F.lds + LDS_MISC + MISC_PART);
        pg8::gemm_phase<pg8::EpiSwiglu8, pg8::MoeOrder, true, true, true>(F.lds, D, So, E, F.wave); }
    SEAM(8);
    if (IN(9)) { RELANE(); load_tp(F);
        const int ntl = __builtin_amdgcn_readfirstlane(tp[32]), nun = ntl * (D / pg8::BM), lfull = (nun / F.G) * F.G, rem = nun - lfull;
        const bool split = rem > 0 && 2 * rem <= F.G;
        pg8::EpiDown E{B_YB, ((const float*)args.in[17]), B_RGATE, 1.0f / (pg8::SC_H * pg8::SC_WD), (LAS float*)(F.lds + LDS_MISC + MISC_PART)};
        { pg8::MoeOrder So; So.init(B_HB8, B_WD8, tp, ntl, D, DE, F.G, F.bx); So.lim = split ? lfull : nun;
          pg8::gemm_phase<pg8::EpiDown, pg8::MoeOrder, true>(F.lds, DE, So, E, F.wave); }
        if (split) { pg8::MoeHalfOrder Sh; Sh.init(B_HB8, B_WD8, tp, ntl, D, DE, F.bx, lfull, rem);
          pg8::gemm_phase<pg8::EpiDown, pg8::MoeHalfOrder, true, true, false, true>(F.lds, DE, Sh, E, F.wave); }
    }
    SEAM(9);
    if (IN(10)) { RELANE(); p10_final(args, F); }
#undef IN
#undef SEAM
#undef RELANE
}

extern "C" void kernel_launch(void* const* d_in, const int* in_sizes, int n_in, void* d_out, int out_size, void* d_ws, size_t ws_size, hipStream_t stream) {
    static int grid = 0;
    if (grid == 0) {
        if (n_in != 20 || in_sizes[0] != S * D || out_size != S * D || ws_size < WS_END) {
            fprintf(stderr, "kernel_launch: unexpected shapes/workspace (n_in %d, in0 %d, out %d, ws %zu, need %zu); nothing launched\n", n_in, n_in > 0 ? in_sizes[0] : -1, out_size, ws_size, (size_t)WS_END); grid = -1; return; }
        int dev = 0, cus = 0, per_cu = 0;
        if (hipGetDevice(&dev) != hipSuccess || hipDeviceGetAttribute(&cus, hipDeviceAttributeMultiprocessorCount, dev) != hipSuccess) { grid = -1; return; }
        if (hipFuncSetAttribute((const void*)mk_fwd, hipFuncAttributeMaxDynamicSharedMemorySize, LDS_BYTES) != hipSuccess) { fprintf(stderr, "kernel_launch: hipFuncSetAttribute failed\n"); grid = -1; return; }
        if (hipOccupancyMaxActiveBlocksPerMultiprocessor(&per_cu, (const void*)mk_fwd, 512, LDS_BYTES) != hipSuccess || per_cu < 1)
            fprintf(stderr, "kernel_launch: note: occupancy query reports %d workgroups per CU\n", per_cu);
        (void)hipGetLastError();
        grid = cus;
    }
    if (grid < 0) return;
    if (hipMemsetAsync((char*)d_ws + WS_CTL, 0, CTL_ZERO_BYTES, stream) != hipSuccess) { fprintf(stderr, "kernel_launch: memset failed\n"); return; }
    Args a{};
    for (int i = 0; i < 20; ++i) a.in[i] = d_in[i];
    a.out = (float*)d_out; a.ws = (unsigned char*)d_ws;
    a.ph_lo = 0; a.ph_hi = N_PHASES;
    hipLaunchKernelGGL(mk_fwd, dim3(grid), dim3(512), LDS_BYTES, stream, a);
}
```

```cpp
#include <hip/hip_runtime.h>
#include <cstdio>
#include <cstdint>

#define LAS __attribute__((address_space(3)))
#define GAS __attribute__((address_space(1)))
typedef unsigned short bf16;
typedef short bf16x8 __attribute__((ext_vector_type(8)));
typedef short s16x4 __attribute__((ext_vector_type(4)));
typedef float f32x4 __attribute__((ext_vector_type(4)));
typedef float f32x2 __attribute__((ext_vector_type(2)));
typedef unsigned u32x4 __attribute__((ext_vector_type(4)));
typedef unsigned u32x2 __attribute__((ext_vector_type(2)));
typedef _Float16 h16x8 __attribute__((ext_vector_type(8)));

constexpr int S = 16384, D = 2048, INW = 10752, AW = 1536, AO = 512, SW = 1024, NE = 32, TOPK = 4, DE = 2048;
constexpr int MAXROWS = 73728;
constexpr float LN_EPS = 1e-5f;
constexpr float ALPHA = 1.18920711500272106672f;

constexpr size_t MiB = 1u << 20;
constexpr size_t WS_CTL = 0, CTL_ZERO_BYTES = 64 * 1024;
constexpr size_t WS_XB = 1 * MiB;
constexpr size_t WS_WIN = WS_XB + 64 * MiB;
constexpr size_t WS_WA = WS_WIN + 42 * MiB;
constexpr size_t WS_WB = WS_WA + 2 * MiB;
constexpr size_t WS_WO = WS_WB + 4 * MiB;
constexpr size_t WS_WGU = WS_WO + 8 * MiB;
constexpr size_t WS_WD = WS_WGU + 512 * MiB;
constexpr size_t WS_SGW = WS_WD + 256 * MiB;
constexpr size_t WS_WRT = WS_SGW + 512 * 1024;
constexpr size_t WS_VST = WS_SGW + 768 * 1024;
constexpr size_t WS_CS = WS_SGW + 1 * MiB;
constexpr size_t WS_QB = WS_CS + 2 * MiB;
constexpr size_t WS_KB = WS_QB + 48 * MiB;
constexpr size_t WS_VB = WS_KB + 48 * MiB;
constexpr size_t WS_ZB = WS_VB + 48 * MiB;
constexpr size_t WS_GT = WS_ZB + 64 * MiB;
constexpr size_t WS_OG = WS_GT + 128 * MiB;
constexpr size_t WS_LSE = WS_OG + 96 * MiB;
constexpr size_t WS_OA = WS_LSE + 1 * MiB;
constexpr size_t WS_SGI = WS_OA + 16 * MiB;
constexpr size_t WS_MRG = WS_SGI + 32 * MiB;
constexpr size_t WS_X1F = WS_MRG + 64 * MiB;
constexpr size_t WS_X1B = WS_X1F + 128 * MiB;
constexpr size_t WS_STOK = WS_X1B + 64 * MiB;
constexpr size_t WS_SGATE = WS_STOK + 2 * MiB;
constexpr size_t WS_INV = WS_SGATE + 2 * MiB;
constexpr size_t WS_RGATE = WS_INV + 1 * MiB;
constexpr size_t WS_XS = WS_RGATE + 1 * MiB;
constexpr size_t WS_HB = WS_XS + 288 * MiB;
constexpr size_t WS_YB = WS_HB + 288 * MiB;
constexpr size_t WS_X8 = WS_YB + 288 * MiB;
constexpr size_t WS_WIN8 = WS_X8 + 32 * MiB;
constexpr size_t WS_END = WS_WIN8 + 17 * MiB;
constexpr int CW_TMO = 0, CW_BAR = 4096, CW_Q1 = 8192;

constexpr int RING_BYTES = 131072;
constexpr int XLP = 2052;
constexpr int LDS_PART = 16 * XLP * 4 + 256;
constexpr int LDS_MISC = LDS_PART + 16384;
constexpr int MISC_BAR = 0;
constexpr int MISC_QS = 16;
constexpr int MISC_TP = 64;
constexpr int MISC_CNT = 256;
constexpr int MISC_BASE = 384;
constexpr int MISC_LC = 512;
constexpr int MISC_LG = 1024;
constexpr int MISC_PART = 4096;
constexpr int LDS_BYTES = LDS_MISC + 8192;
static_assert(LDS_PART >= RING_BYTES && LDS_BYTES <= 163840, "LDS map");

__device__ __forceinline__ unsigned cvt_pk_bf16(float lo, float hi) { unsigned r; asm volatile("v_cvt_pk_bf16_f32 %0, %1, %2" : "=v"(r) : "v"(lo), "v"(hi)); return r; }
__device__ __forceinline__ float bflo(unsigned w) { return __uint_as_float(w << 16); }
__device__ __forceinline__ float bfhi(unsigned w) { return __uint_as_float(w & 0xffff0000u); }
__device__ __forceinline__ float wave_sum(float v) {
#pragma unroll
    for (int o = 1; o < 64; o <<= 1) v += __shfl_xor(v, o);
    return v;
}
__device__ __forceinline__ float fast_exp2(float x) { return __builtin_amdgcn_exp2f(x); }
__device__ __forceinline__ float sigmoidf_(float x) { return __builtin_amdgcn_rcpf(1.0f + fast_exp2(-1.44269504089f * x)); }

__device__ __forceinline__ int hw_lane() { int l; asm volatile("v_mbcnt_lo_u32_b32 %0, -1, 0\n\tv_mbcnt_hi_u32_b32 %0, -1, %0" : "=v"(l)); return l; }

#define XB_TMO      128
#define XB_XCNT(j)  (256  + 64 * (j))
#define XB_XSUB(j)  (1280 + 64 * (j))
#define XB_XGEN(j)  (2304 + 64 * (j))
#define XB_TOP      3328
#define XB_TOPGEN   3392
#define XCD_BAR_WORDS 3456
#define XB_SPIN_CAP (1u << 18)
__device__ __forceinline__ unsigned xb_ld(unsigned* p)              { return __hip_atomic_load(p, __ATOMIC_RELAXED, __HIP_MEMORY_SCOPE_AGENT); }
__device__ __forceinline__ unsigned xb_add(unsigned* p, unsigned v) { return __hip_atomic_fetch_add(p, v, __ATOMIC_RELAXED, __HIP_MEMORY_SCOPE_AGENT); }
__device__ __forceinline__ unsigned xb_xcc_id() { return (unsigned)__builtin_amdgcn_s_getreg((3 << 11) | 20) & 0xFu; }
#define XB_SPIN(cond, bar) do { unsigned _sp = 0; while (cond) { __builtin_amdgcn_s_sleep(1); \
    if ((++_sp & 255u) == 0u) { if (xb_ld(&(bar)[XB_TMO])) break; if (_sp > XB_SPIN_CAP) { atomicAdd(&(bar)[XB_TMO], 1u); break; } } } } while (0)
struct XcdBarrier { unsigned* bar; unsigned x; volatile LAS unsigned* st; };
__device__ __forceinline__ XcdBarrier xcd_barrier_post(unsigned* bar, volatile LAS unsigned* st, bool t0) {
    XcdBarrier b; b.bar = bar; b.x = xb_xcc_id(); b.st = st;
    if (t0) (void)xb_add(&bar[XB_XCNT(b.x)], 1u);
    return b;
}
__device__ __forceinline__ void xcd_barrier_complete(unsigned* bar, unsigned x, unsigned& nloc, unsigned& nx) {
    const unsigned G = gridDim.x * gridDim.y * gridDim.z;
    unsigned sum, cnt, mine, sp = 0u;
    for (;;) {
        sum = 0u; cnt = 0u; mine = 0u;
#pragma unroll
        for (unsigned j = 0; j < 16; ++j) { const unsigned c = xb_ld(&bar[XB_XCNT(j)]); sum += c; cnt += (c > 0u) ? 1u : 0u; mine = (j == x) ? c : mine; }
        if (sum == G) break;
        __builtin_amdgcn_s_sleep(1);
        if ((++sp & 255u) == 0u) { if (xb_ld(&bar[XB_TMO])) break; if (sp > XB_SPIN_CAP) { atomicAdd(&bar[XB_TMO], 1u); break; } }
    }
    nloc = mine > 0u ? mine : 1u; nx = cnt > 0u ? cnt : 1u;
}
__device__ __forceinline__ void xcd_barrier(const XcdBarrier& b, bool t0) {
    asm volatile("s_waitcnt vmcnt(0)" ::: "memory");
    __syncthreads();
    if (t0) {
        unsigned* bar = b.bar;
        __builtin_amdgcn_s_waitcnt(0);
        unsigned nloc = b.st[0], nx = b.st[1];
        if (nloc == 0u) { xcd_barrier_complete(bar, b.x, nloc, nx); b.st[0] = nloc; b.st[1] = nx; }
        const unsigned old = xb_add(&bar[XB_XSUB(b.x)], 1u);
        const unsigned gen = old / nloc;
        if (old + 1u == (gen + 1u) * nloc) {
            __builtin_amdgcn_fence(__ATOMIC_RELEASE, "agent");
            asm volatile("s_waitcnt vmcnt(0)" ::: "memory");
            const unsigned og = xb_add(&bar[XB_TOP], 1u);
            const unsigned tg = og / nx;
            if (og + 1u == (tg + 1u) * nx) xb_add(&bar[XB_TOPGEN], 1u);
            else XB_SPIN(xb_ld(&bar[XB_TOPGEN]) == tg, bar);
            __builtin_amdgcn_fence(__ATOMIC_ACQUIRE, "agent");
            asm volatile("s_waitcnt vmcnt(0)" ::: "memory");
        } else {
            XB_SPIN(xb_ld(&bar[XB_TOPGEN]) == gen, bar);
            __builtin_amdgcn_fence(__ATOMIC_ACQUIRE, "agent");
            asm volatile("s_waitcnt vmcnt(0)" ::: "memory");
        }
    }
    __syncthreads();
}

namespace pg8 {
constexpr int BM = 256, BK = 64, HALF = 128, HTB = HALF * BK * 2, STAGE_BYTES = 8 * HTB, NXCD = 8;
#ifndef WGM_D
#define WGM_D 4
#endif
#ifndef WGM_M
#define WGM_M 8
#endif
#ifndef WGM_QQ
#define WGM_QQ 4
#endif
constexpr int WGM = WGM_D, WGM_MOE = WGM_M, WGM_Q = WGM_QQ;
__host__ __device__ __forceinline__ int lds_byte(int r, int c) { const int st = (r >> 4) * 2 + (c >> 5), rr = r & 15, cc = c & 31, ob = rr * 64 + cc * 2; return st * 1024 + (ob ^ (((ob >> 9) & 1) << 5)); }
__host__ __device__ __forceinline__ void stage_rc(int b, int& R, int& C) { const int st = b / 1024, sb = b % 1024, swz = sb ^ (((sb >> 9) & 1) << 5); R = (st >> 1) * 16 + swz / 64; C = (st & 1) * 32 + (swz % 64) / 2; }
__host__ __device__ __forceinline__ int perm32(int rho) { const int n = rho >> 4, i = rho & 15; return 8 * (i >> 2) + 4 * n + (i & 3); }

struct Unit { const char* a; const char* b; int pm, pn, e, pad; };

__device__ __forceinline__ bool tile_of(long L, int nM, int nN, int& pm, int& pn, int wgm = WGM) {
    const int nwg = nM * nN; if (L >= nwg) return false;
    int wgid = (int)L; { const int q = nwg / NXCD, r = nwg % NXCD, xcd = wgid % NXCD, off = wgid / NXCD; wgid = (xcd < r ? xcd * (q + 1) : r * (q + 1) + (xcd - r) * q) + off; }
    const int nig = wgm * nN, gid = wgid / nig, fm = gid * wgm, gsz = (nM - fm) < wgm ? (nM - fm) : wgm;
    pm = fm + ((wgid % nig) % gsz); pn = (wgid % nig) / gsz; return true;
}
struct DenseOrder {
    const char* A; const char* Bt; int nM, nN, G, c, wgm = WGM; size_t tstep;
    __device__ __forceinline__ void init(const void* A_, const void* Bt_, int M, int N, int KB, int G_, int c_) { A = (const char*)A_; Bt = (const char*)Bt_; nM = M / BM; nN = N / BM; G = G_; c = c_; tstep = (size_t)BM * KB; }
    __device__ __forceinline__ bool next(int i, Unit& u) const {
        int pm, pn; if (!tile_of((long)i * G + c, nM, nN, pm, pn, wgm)) return false;
        u.pm = pm; u.pn = pn; u.e = 0; u.pad = 0; u.a = A + (size_t)pm * tstep; u.b = Bt + (size_t)pn * tstep; return true; }
    __device__ __forceinline__ void a_ready(const Unit&) const {}
    __device__ __forceinline__ void done(const Unit&) const {}
};
struct MoeOrder {
    const char* A; const char* Bt; const LAS int* tp; int nM, nN, G, c, wgm = WGM_MOE; size_t tstep, estep;
    int lim = 0x7fffffff;
    const int* rowtok = nullptr; LAS unsigned* ids = nullptr;
    __device__ __forceinline__ void init(const void* A_, const void* Bt_, const LAS int* tp_, int ntiles, int N, int KB, int G_, int c_) {
        A = (const char*)A_; Bt = (const char*)Bt_; tp = tp_; nM = ntiles; nN = N / BM; G = G_; c = c_; tstep = (size_t)BM * KB; estep = (size_t)N * KB; }
    __device__ __forceinline__ bool next(int i, Unit& u) const {
        int pm, pn; if ((long)i * G + c >= lim || !tile_of((long)i * G + c, nM, nN, pm, pn, wgm)) return false;
        const int lane = hw_lane(); const int v = (lane < 32) ? tp[lane + 1] : 0x7fffffff;
        const int e = __popcll(__ballot(v <= pm));
        u.pm = pm; u.pn = pn; u.e = e; u.pad = 0; u.a = rowtok ? A : A + (size_t)pm * tstep; u.b = Bt + (size_t)e * estep + (size_t)pn * tstep; return true; }
    __device__ __forceinline__ void a_ready(const Unit&) const {}
    __device__ __forceinline__ void done(const Unit&) const {}
};

struct MoeHalfOrder {
    const char* A; const char* Bt; const LAS int* tp; int nM, nN, c, l0, R, wgm = WGM_MOE, KB; size_t tstep, estep;
    __device__ __forceinline__ void init(const void* A_, const void* Bt_, const LAS int* tp_, int ntiles, int N, int KB_, int c_, int l0_, int R_) {
        A = (const char*)A_; Bt = (const char*)Bt_; tp = tp_; nM = ntiles; nN = N / BM; c = c_; l0 = l0_; R = R_; KB = KB_; tstep = (size_t)BM * KB_; estep = (size_t)N * KB_; }
    __device__ __forceinline__ bool next(int i, Unit& u) const {
        int pm, pn; if (i > 0 || c >= 2 * R || !tile_of((long)l0 + (c >> 1), nM, nN, pm, pn, wgm)) return false;
        const int lane = hw_lane(); const int v = (lane < 32) ? tp[lane + 1] : 0x7fffffff;
        const int e = __popcll(__ballot(v <= pm)), ro = (c & 1) * HALF;
        u.pm = pm; u.pn = pn; u.e = e; u.pad = ro; u.a = A + (size_t)pm * tstep + (size_t)ro * KB; u.b = Bt + (size_t)e * estep + (size_t)pn * tstep; return true; }
    __device__ __forceinline__ void a_ready(const Unit&) const {}
    __device__ __forceinline__ void done(const Unit&) const {}
};

struct QueueOrder {
    const char* A; const char* Bt; int nM, nN, nwg, per, x0, wave; size_t tstep; unsigned* head; volatile LAS unsigned* slot;
    mutable int k, seq;
    __device__ __forceinline__ void init(const void* A_, const void* Bt_, int M, int N, int KB, unsigned* head_, volatile LAS unsigned* slot_, int xcd, int wave_) {
        A = (const char*)A_; Bt = (const char*)Bt_; nM = M / BM; nN = N / BM; tstep = (size_t)BM * KB; slot = slot_; head = head_;
        nwg = nM * nN; per = (nwg + NXCD - 1) / NXCD; x0 = xcd & (NXCD - 1); k = 0; seq = 0; wave = wave_; }
    __device__ __forceinline__ bool next(int, Unit& u) const {
        int L;
        for (;;) {
            if (k >= NXCD) return false;
            const int q = (x0 + k) & (NXCD - 1), lo = q * per, hi = lo + per < nwg ? lo + per : nwg;
            if (wave == 0) {
                if (hw_lane() == 0) slot[seq & 1] = __hip_atomic_fetch_add(head + 64 * q, 1u, __ATOMIC_RELAXED, __HIP_MEMORY_SCOPE_AGENT);
                asm volatile("s_waitcnt vmcnt(0) lgkmcnt(0)" ::: "memory");
            }
            asm volatile("" ::: "memory"); __builtin_amdgcn_s_barrier(); asm volatile("" ::: "memory");
            L = lo + __builtin_amdgcn_readfirstlane((int)slot[seq & 1]); ++seq;
            if (L < hi) break;
            ++k;
        }
        const int nig = WGM_Q * nN, gid = L / nig, fm = gid * WGM_Q, gsz = (nM - fm) < WGM_Q ? (nM - fm) : WGM_Q;
        const int pm = fm + ((L % nig) % gsz), pn = (L % nig) / gsz;
        u.pm = pm; u.pn = pn; u.e = 0; u.pad = 0; u.a = A + (size_t)pm * tstep; u.b = Bt + (size_t)pn * tstep; return true; }
    __device__ __forceinline__ void a_ready(const Unit&) const {}
    __device__ __forceinline__ void done(const Unit&) const {}
};

typedef f32x4 Acc[2][2][4][2];
__device__ __forceinline__ f32x2 gelu_pk(f32x2 v) {
    const f32x2 av = __builtin_elementwise_abs(v), d = av * 0.2316418882f + 1.0f;
    f32x2 t; t.x = __builtin_amdgcn_rcpf(d.x); t.y = __builtin_amdgcn_rcpf(d.y);
    f32x2 q = t * 0.5307027145f + (-0.7265760135f); q = q * t + 0.7107068705f; q = q * t + (-0.142248368f); q = q * t + 0.127414796f; q = q * t;
    const f32x2 s = (v * v) * (-0.72134752044f);
    f32x2 e; e.x = __builtin_amdgcn_exp2f(s.x); e.y = __builtin_amdgcn_exp2f(s.y);
    const f32x2 m = v * (q * e), r = v - m;
    f32x2 o; o.x = v.x < 0.f ? m.x : r.x; o.y = v.y < 0.f ? m.y : r.y; return o;
}

__device__ __forceinline__ unsigned pk4_fp8(float a, float b, float c, float d) { int w = 0; w = __builtin_amdgcn_cvt_pk_fp8_f32(a, b, w, false); w = __builtin_amdgcn_cvt_pk_fp8_f32(c, d, w, true); return (unsigned)w; }
__device__ __forceinline__ float clamp448(float v) { return fminf(fmaxf(v, -448.0f), 448.0f); }
constexpr float SC_X1 = 16.0f, SC_WGU = 512.0f, SC_H = 4.0f, SC_WD = 1024.0f;
constexpr float SC_MRG = 16.0f, SC_WO = 1024.0f;
constexpr float SC_Y = 128.0f;
__device__ __forceinline__ float sat448(float v) { return __builtin_amdgcn_fmed3f(v, -448.0f, 448.0f); }
__device__ __forceinline__ float sat8(float v) { return __builtin_amdgcn_fmed3f(v * SC_MRG, -448.0f, 448.0f); }
struct EpiIn {
    struct Pre {}; __device__ __forceinline__ void prefetch(Pre&, const Unit&, int, int, int, int) const {}
    static constexpr bool PERM = true, AFTER_DRAIN = false;
    bf16 *QB, *KB, *VB, *ZB, *GT; const float* cs; int pn_off; float sc;
    __device__ __forceinline__ void operator()(const Acc& acc, const Unit& u, int wr, int wc, int fr, int fq, const Pre&) const {
        const int pn = (pn_off == 0 && u.pn >= 18) ? u.pn + 8 : u.pn + pn_off; bf16* base; int ldc, colt, mode;
        if (pn < 6) { base = QB; ldc = AW; colt = 256 * pn; mode = 1; }
        else if (pn < 12) { base = KB; ldc = AW; colt = 256 * (pn - 6); mode = 1; }
        else if (pn < 18) { base = VB; ldc = AW; colt = 256 * (pn - 12); mode = 0; }
        else if (pn < 26) { base = ZB; ldc = 2048; colt = 256 * (pn - 18); mode = 2; }
        else { base = GT; ldc = 4096; colt = 256 * (pn - 26); mode = 3; }
        const int row0 = u.pm * BM + wr * 64 + fr, col0 = colt + wc * 32 + 8 * fq;
        const bool rope = (mode == 1) && (wc == 0);
#pragma unroll
        for (int ai = 0; ai < 2; ++ai)
#pragma unroll
            for (int m = 0; m < 4; ++m) {
                const int row = row0 + ai * HALF + m * 16;
                f32x4 cs4[4];
                if (rope) { const f32x4* cp = (const f32x4*)(cs + ((size_t)row * 16 + 8 * (fq & 1)) * 2);
#pragma unroll
                    for (int q = 0; q < 4; ++q) cs4[q] = cp[q]; }
                bf16* rowp = base + (size_t)row * ldc + col0;
#pragma unroll
                for (int bj = 0; bj < 2; ++bj) {
                    f32x4 v0 = acc[ai][bj][m][0] * sc, v1 = acc[ai][bj][m][1] * sc;
                    if (rope) {
                        float x[8] = {v0[0], v0[1], v0[2], v0[3], v1[0], v1[1], v1[2], v1[3]};
#pragma unroll
                        for (int i = 0; i < 8; ++i) {
                            const float y = __shfl_xor(x[i], 32);
                            const float c = cs4[i >> 1][(i & 1) * 2], s = cs4[i >> 1][(i & 1) * 2 + 1];
                            x[i] = (fq < 2) ? (x[i] * c - y * s) : (x[i] * c + y * s);
                        }
                        v0 = (f32x4){x[0], x[1], x[2], x[3]}; v1 = (f32x4){x[4], x[5], x[6], x[7]};
                    }
                    if (mode == 2) { f32x2 a = gelu_pk((f32x2){v0[0], v0[1]}), b = gelu_pk((f32x2){v0[2], v0[3]}), c = gelu_pk((f32x2){v1[0], v1[1]}), d = gelu_pk((f32x2){v1[2], v1[3]});
                        v0 = (f32x4){a.x, a.y, b.x, b.y}; v1 = (f32x4){c.x, c.y, d.x, d.y}; }
                    if (mode == 3) {
                        const float ce = -1.44269504089f * sc;
                        const f32x4 a0 = acc[ai][bj][m][0], a1 = acc[ai][bj][m][1];
                        const f32x2 e0 = (f32x2){a0[0], a0[1]} * ce, e1 = (f32x2){a0[2], a0[3]} * ce, e2 = (f32x2){a1[0], a1[1]} * ce, e3 = (f32x2){a1[2], a1[3]} * ce;
                        f32x2 t0, t1, t2, t3;
                        t0.x = __builtin_amdgcn_exp2f(e0.x); t0.y = __builtin_amdgcn_exp2f(e0.y); t1.x = __builtin_amdgcn_exp2f(e1.x); t1.y = __builtin_amdgcn_exp2f(e1.y);
                        t2.x = __builtin_amdgcn_exp2f(e2.x); t2.y = __builtin_amdgcn_exp2f(e2.y); t3.x = __builtin_amdgcn_exp2f(e3.x); t3.y = __builtin_amdgcn_exp2f(e3.y);
                        t0 = t0 + 1.0f; t1 = t1 + 1.0f; t2 = t2 + 1.0f; t3 = t3 + 1.0f;
                        v0 = (f32x4){__builtin_amdgcn_rcpf(t0.x), __builtin_amdgcn_rcpf(t0.y), __builtin_amdgcn_rcpf(t1.x), __builtin_amdgcn_rcpf(t1.y)};
                        v1 = (f32x4){__builtin_amdgcn_rcpf(t2.x), __builtin_amdgcn_rcpf(t2.y), __builtin_amdgcn_rcpf(t3.x), __builtin_amdgcn_rcpf(t3.y)}; }
                    u32x4 w; w.x = cvt_pk_bf16(v0[0], v0[1]); w.y = cvt_pk_bf16(v0[2], v0[3]); w.z = cvt_pk_bf16(v1[0], v1[1]); w.w = cvt_pk_bf16(v1[2], v1[3]);
                    *(u32x4*)(rowp + bj * HALF) = w;
                }
            }
    }
};
template <bool OUT8>
struct EpiGateT {
    struct Pre {}; __device__ __forceinline__ void prefetch(Pre&, const Unit&, int, int, int, int) const {}
    static constexpr bool PERM = true, AFTER_DRAIN = false;
    bf16* MRG; const bf16* GT; int goff; int accum; unsigned char* MRG8;
    __device__ __forceinline__ void operator()(const Acc& acc, const Unit& u, int wr, int wc, int fr, int fq, const Pre&) const {
        const int row0 = u.pm * BM + wr * 64 + fr, col0 = u.pn * BM + wc * 32 + 8 * fq;
#pragma unroll
        for (int ai = 0; ai < 2; ++ai)
#pragma unroll
            for (int m = 0; m < 4; ++m) {
                const int row = row0 + ai * HALF + m * 16;
#pragma unroll
                for (int bj = 0; bj < 2; ++bj) {
                    const int col = col0 + bj * HALF;
                    const u32x4 g = *(const u32x4*)(GT + (size_t)row * 4096 + goff + col);
                    bf16* op = MRG + (size_t)row * D + col;
                    f32x4 v0 = acc[ai][bj][m][0], v1 = acc[ai][bj][m][1];
                    v0[0] *= bflo(g.x); v0[1] *= bfhi(g.x); v0[2] *= bflo(g.y); v0[3] *= bfhi(g.y);
                    v1[0] *= bflo(g.z); v1[1] *= bfhi(g.z); v1[2] *= bflo(g.w); v1[3] *= bfhi(g.w);
                    if (accum) { const u32x4 o = *(const u32x4*)op;
                        v0[0] += bflo(o.x); v0[1] += bfhi(o.x); v0[2] += bflo(o.y); v0[3] += bfhi(o.y);
                        v1[0] += bflo(o.z); v1[1] += bfhi(o.z); v1[2] += bflo(o.w); v1[3] += bfhi(o.w); }
                    if constexpr (OUT8) {
                        u32x2 w; w.x = pk4_fp8(sat8(v0[0]), sat8(v0[1]), sat8(v0[2]), sat8(v0[3])); w.y = pk4_fp8(sat8(v1[0]), sat8(v1[1]), sat8(v1[2]), sat8(v1[3]));
                        *(u32x2*)(MRG8 + (size_t)row * D + col) = w; }
                    else { u32x4 w; w.x = cvt_pk_bf16(v0[0], v0[1]); w.y = cvt_pk_bf16(v0[2], v0[3]); w.z = cvt_pk_bf16(v1[0], v1[1]); w.w = cvt_pk_bf16(v1[2], v1[3]);
                        *(u32x4*)op = w; }
                }
            }
    }
};
struct EpiX1 {
    struct Pre {}; __device__ __forceinline__ void prefetch(Pre&, const Unit&, int, int, int, int) const {}
    static constexpr bool PERM = true, AFTER_DRAIN = false;
    const bf16* xb; bf16* X1F; float sc;
    __device__ __forceinline__ void operator()(const Acc& acc, const Unit& u, int wr, int wc, int fr, int fq, const Pre&) const {
        const int row0 = u.pm * BM + wr * 64 + fr, col0 = u.pn * BM + wc * 32 + 8 * fq;
#pragma unroll
        for (int ai = 0; ai < 2; ++ai)
#pragma unroll
            for (int m = 0; m < 4; ++m) { const size_t off = (size_t)(row0 + ai * HALF + m * 16) * D + col0;
#pragma unroll
                for (int bj = 0; bj < 2; ++bj) { const u32x4 xv = *(const u32x4*)(xb + off + bj * HALF);
                    f32x4 v0 = acc[ai][bj][m][0] * sc, v1 = acc[ai][bj][m][1] * sc;
                    v0[0] += ALPHA * bflo(xv.x); v0[1] += ALPHA * bfhi(xv.x); v0[2] += ALPHA * bflo(xv.y); v0[3] += ALPHA * bfhi(xv.y);
                    v1[0] += ALPHA * bflo(xv.z); v1[1] += ALPHA * bfhi(xv.z); v1[2] += ALPHA * bflo(xv.w); v1[3] += ALPHA * bfhi(xv.w);
                    u32x4 w; w.x = cvt_pk_bf16(v0[0], v0[1]); w.y = cvt_pk_bf16(v0[2], v0[3]); w.z = cvt_pk_bf16(v1[0], v1[1]); w.w = cvt_pk_bf16(v1[2], v1[3]);
                    *(u32x4*)(X1F + off + bj * HALF) = w; } }
    }
};
struct EpiSwiglu8 {
    struct Pre { f32x4 bg0, bg1, bu0, bu1; };
    static constexpr bool PERM = true, AFTER_DRAIN = false;
    unsigned char* HB8; const float* bgu;
    __device__ __forceinline__ void prefetch(Pre& P, const Unit& u, int wr, int wc, int fr, int fq) const {
        const float* bg = bgu + (size_t)u.e * (2 * DE) + u.pn * HALF + wc * 32 + 8 * fq;
        P.bg0 = *(const f32x4*)bg; P.bg1 = *(const f32x4*)(bg + 4); P.bu0 = *(const f32x4*)(bg + DE); P.bu1 = *(const f32x4*)(bg + DE + 4); }
    __device__ __forceinline__ void operator()(const Acc& acc, const Unit& u, int wr, int wc, int fr, int fq, const Pre& P) const {
        const int row0 = u.pm * BM + wr * 64 + fr, ch0 = u.pn * HALF + wc * 32 + 8 * fq;
        const float isc = 1.0f / (SC_X1 * SC_WGU), ce = -1.702f * 1.44269504089f, qh = 1.0f / SC_H;
        const f32x2 bg[4] = {(f32x2){P.bg0[0], P.bg0[1]}, (f32x2){P.bg0[2], P.bg0[3]}, (f32x2){P.bg1[0], P.bg1[1]}, (f32x2){P.bg1[2], P.bg1[3]}};
        const f32x2 bu[4] = {(f32x2){P.bu0[0] + 1.0f, P.bu0[1] + 1.0f}, (f32x2){P.bu0[2] + 1.0f, P.bu0[3] + 1.0f}, (f32x2){P.bu1[0] + 1.0f, P.bu1[1] + 1.0f}, (f32x2){P.bu1[2] + 1.0f, P.bu1[3] + 1.0f}};
#pragma unroll
        for (int ai = 0; ai < 2; ++ai)
#pragma unroll
            for (int m = 0; m < 4; ++m) {
                const int row = row0 + ai * HALF + m * 16;
                f32x2 h[4];
#pragma unroll
                for (int p = 0; p < 4; ++p) {
                    const f32x4 ag = acc[ai][0][m][p >> 1], au = acc[ai][1][m][p >> 1];
                    f32x2 g = (f32x2){ag[2 * (p & 1)], ag[2 * (p & 1) + 1]} * isc + bg[p];
                    f32x2 u1 = (f32x2){au[2 * (p & 1)], au[2 * (p & 1) + 1]} * isc + bu[p];
                    g = __builtin_elementwise_min(g, (f32x2){7.0f, 7.0f});
                    u1 = __builtin_elementwise_min(__builtin_elementwise_max(u1, (f32x2){-6.0f, -6.0f}), (f32x2){8.0f, 8.0f});
                    const f32x2 ge = g * ce;
                    f32x2 t; t.x = __builtin_amdgcn_exp2f(ge.x); t.y = __builtin_amdgcn_exp2f(ge.y);
                    const f32x2 d = t * qh + qh;
                    f32x2 s; s.x = __builtin_amdgcn_rcpf(d.x); s.y = __builtin_amdgcn_rcpf(d.y);
                    h[p] = (u1 * g) * s;
                }
                u32x2 w; w.x = pk4_fp8(h[0].x, h[0].y, h[1].x, h[1].y); w.y = pk4_fp8(h[2].x, h[2].y, h[3].x, h[3].y);
                *(u32x2*)(HB8 + (size_t)row * DE + ch0) = w;
            }
    }
};
struct EpiDown {
    struct Pre {};
    static constexpr bool PERM = true, AFTER_DRAIN = false;
    unsigned char* YB; const float* bd; const float* rgate; float isc; LAS float* epi;
    __device__ __forceinline__ void prefetch(Pre&, const Unit& u, int wr, int wc, int fr, int fq) const {
        const int wid = wr * 4 + wc, lane = fq * 16 + fr;
        const float* src = (wid < 4) ? (rgate + u.pm * BM + u.pad + 64 * wid + lane) : (bd + (size_t)u.e * D + u.pn * BM + 64 * (wid - 4) + lane);
        __builtin_amdgcn_global_load_lds((const unsigned*)src, (LAS unsigned*)(epi + 64 * wid), 4, 0, 0);
    }
    __device__ __forceinline__ void operator()(const Acc& acc, const Unit& u, int wr, int wc, int fr, int fq, const Pre& p) const { run<2>(acc, u, wr, wc, fr, fq, p); }
    __device__ __forceinline__ void half(const Acc& acc, const Unit& u, int wr, int wc, int fr, int fq, const Pre& p) const { run<1>(acc, u, wr, wc, fr, fq, p); }
    template <int NAI>
    __device__ __forceinline__ void run(const Acc& acc, const Unit& u, int wr, int wc, int fr, int fq, const Pre&) const {
        const int row0 = u.pm * BM + u.pad + wr * 64 + fr, col0 = u.pn * BM + wc * 32 + 8 * fq;
        f32x4 bv[2][2];
#pragma unroll
        for (int bj = 0; bj < 2; ++bj)
#pragma unroll
            for (int n = 0; n < 2; ++n) bv[bj][n] = *(const LAS f32x4*)(epi + 256 + wc * 32 + 8 * fq + bj * HALF + 4 * n);
#pragma unroll
        for (int ai = 0; ai < NAI; ++ai)
#pragma unroll
            for (int m = 0; m < 4; ++m) {
                const int row = row0 + ai * HALF + m * 16; const float gt = epi[wr * 64 + fr + ai * HALF + m * 16] * SC_Y;
#pragma unroll
                for (int bj = 0; bj < 2; ++bj) {
                    const f32x4 v0 = (acc[ai][bj][m][0] * isc + bv[bj][0]) * gt, v1 = (acc[ai][bj][m][1] * isc + bv[bj][1]) * gt;
                    u32x2 w; w.x = pk4_fp8(sat448(v0[0]), sat448(v0[1]), sat448(v0[2]), sat448(v0[3])); w.y = pk4_fp8(sat448(v1[0]), sat448(v1[1]), sat448(v1[2]), sat448(v1[3]));
                    *(u32x2*)(YB + (size_t)row * D + col0 + bj * HALF) = w;
                }
            }
    }
};

typedef int i32x8 __attribute__((ext_vector_type(8)));
typedef short s16x16 __attribute__((ext_vector_type(16)));
typedef int i32x4 __attribute__((ext_vector_type(4)));
__device__ __forceinline__ bf16x8 lo8(i32x8 v) { return __builtin_bit_cast(bf16x8, __builtin_shufflevector(v, v, 0, 1, 2, 3)); }
__device__ __forceinline__ bf16x8 hi8(i32x8 v) { return __builtin_bit_cast(bf16x8, __builtin_shufflevector(v, v, 4, 5, 6, 7)); }
__device__ __forceinline__ void mfma_fp8(f32x4& c, const i32x8& a, const i32x8& b) { asm volatile("v_mfma_f32_16x16x128_f8f6f4 %0, %1, %2, %0" : "+v"(c) : "v"(a), "v"(b)); }
template <class Epi, class Sched, bool FP8 = false, bool ALIGN_EPI = true, bool GATHER = false, bool HALFM = false>
__device__ __forceinline__ void gemm_phase(LAS unsigned char* lds, const int KB, const Sched& S, const Epi& E, const int wave) {
    const int lane = hw_lane(), wid = wave, tid = wid * 64 + lane,
              wr = wid >> 2, wc = wid & 3, fr = lane & 15, fq = lane >> 4;
    const int nt = KB / 128;
    unsigned voffA[2], voffB[2];
#pragma unroll
    for (int i = 0; i < 2; ++i) { int R, C; stage_rc(tid * 16 + i * 8192, R, C); const int Rb = Epi::PERM ? ((R & ~31) + perm32(R & 31)) : R;
        voffA[i] = (unsigned)(R * KB + C * 2); voffB[i] = (unsigned)(Rb * KB + C * 2); }
    const size_t kstep = (size_t)(BK * 2);
    const size_t hstep = (size_t)HALF * KB;
    const unsigned ldsw = (unsigned)wid * 1024u;
    const int aoff = lds_byte(wr * 64 + fr, fq * 8), boff = lds_byte(wc * 32 + fr, fq * 8);
#define PG8_SA(b, h) (((b) * 2 + (h)) * HTB)
#define PG8_SB(b, h) ((4 + (b) * 2 + (h)) * HTB)
#define PG8_STAGE(bufoff, gbase, voff) do { _Pragma("unroll") for (int _i = 0; _i < 2; ++_i) \
        __builtin_amdgcn_global_load_lds((const unsigned*)((const char*)(gbase) + (voff)[_i]), (LAS unsigned*)(lds + (bufoff) + ldsw + _i * 8192), 16, 0, 0); } while (0)
#define PG8_STA(bufoff, kp, h) do { if constexpr (GATHER) { _Pragma("unroll") for (int _i = 0; _i < 2; ++_i) \
        __builtin_amdgcn_global_load_lds((const unsigned*)((const char*)(kp) + gc[h][_i]), (LAS unsigned*)(lds + (bufoff) + ldsw + _i * 8192), 16, 0, 0); } \
        else { PG8_STAGE(bufoff, (kp) + (h) * hstep, voffA); } } while (0)
#define PG8_GFETCH(u) do { if constexpr (GATHER) { if (wid < 4) __builtin_amdgcn_global_load_lds((const unsigned*)(S.rowtok + (u).pm * BM + 64 * wid + lane), (LAS unsigned*)(S.ids + 64 * wid), 4, 0, 0); } } while (0)
#define PG8_GREAD() do { if constexpr (GATHER) { _Pragma("unroll") for (int _h = 0; _h < 2; ++_h) _Pragma("unroll") for (int _i = 0; _i < 2; ++_i) { int R_, C_; stage_rc(tid * 16 + _i * 8192, R_, C_); \
        gc[_h][_i] = S.ids[_h * HALF + R_] * (unsigned)KB + (unsigned)(C_ * 2); } } } while (0)
#define PG8_LDA(dst, b, h) do { _Pragma("unroll") for (int m = 0; m < 4; ++m) { const i32x4 _l = *(const LAS i32x4*)(lds + PG8_SA(b, h) + aoff + m * 2048), _h = *(const LAS i32x4*)(lds + PG8_SA(b, h) + aoff + m * 2048 + 1024); \
        dst[m] = __builtin_shufflevector(_l, _h, 0, 1, 2, 3, 4, 5, 6, 7); } } while (0)
#define PG8_LDB(dst, b, h) do { _Pragma("unroll") for (int n = 0; n < 2; ++n) { const i32x4 _l = *(const LAS i32x4*)(lds + PG8_SB(b, h) + boff + n * 2048), _h = *(const LAS i32x4*)(lds + PG8_SB(b, h) + boff + n * 2048 + 1024); \
        dst[n] = __builtin_shufflevector(_l, _h, 0, 1, 2, 3, 4, 5, 6, 7); } } while (0)
#define PG8_MMA(ai, bj, At, Bt) do { __builtin_amdgcn_s_setprio(1); _Pragma("unroll") for (int m = 0; m < 4; ++m) _Pragma("unroll") for (int n = 0; n < 2; ++n) { \
        if constexpr (FP8) { mfma_fp8(acc[ai][bj][m][n], Bt[n], At[m]); } \
        else { acc[ai][bj][m][n] = __builtin_amdgcn_mfma_f32_16x16x32_bf16(lo8(Bt[n]), lo8(At[m]), acc[ai][bj][m][n], 0, 0, 0); \
               acc[ai][bj][m][n] = __builtin_amdgcn_mfma_f32_16x16x32_bf16(hi8(Bt[n]), hi8(At[m]), acc[ai][bj][m][n], 0, 0, 0); } } __builtin_amdgcn_s_setprio(0); } while (0)
#define PG8_WAIT_V(n) asm volatile("s_waitcnt vmcnt(" #n ")" ::: "memory")
#define PG8_WAIT_L(n) asm volatile("s_waitcnt lgkmcnt(" #n ")" ::: "memory")
#define PG8_BAR __builtin_amdgcn_s_barrier()
#define PG8_SCHED __builtin_amdgcn_sched_barrier(0)
    Unit cur, nxt; int ui = 0;
    if (!S.next(0, cur)) return;
    f32x4 acc[2][2][4][2];
#pragma unroll
    for (int a = 0; a < 2; ++a)
#pragma unroll
        for (int b = 0; b < 2; ++b)
#pragma unroll
            for (int m = 0; m < 4; ++m)
#pragma unroll
                for (int n = 0; n < 2; ++n) acc[a][b][m][n] = (f32x4){0.f, 0.f, 0.f, 0.f};
    typename Epi::Pre pre;
    i32x8 At[4], B0[2], B1[2];
    const char* cA = cur.a; const char* cB = cur.b;
    S.a_ready(cur);
    unsigned gc[2][2] = {{0u, 0u}, {0u, 0u}};
    if constexpr (GATHER) { PG8_GFETCH(cur); PG8_WAIT_V(0); PG8_BAR; PG8_GREAD(); PG8_WAIT_L(0); PG8_BAR; }
    PG8_STAGE(PG8_SB(0, 0), cB, voffB); PG8_STAGE(PG8_SB(0, 1), cB + hstep, voffB); PG8_STA(PG8_SA(0, 0), cA, 0); PG8_STA(PG8_SA(0, 1), cA, 1);
    if (wr == 1) PG8_BAR;
    PG8_WAIT_V(2); PG8_BAR;
    PG8_STAGE(PG8_SB(1, 0), cB + kstep, voffB); PG8_STA(PG8_SA(1, 0), cA + kstep, 0); PG8_STAGE(PG8_SB(1, 1), cB + hstep + kstep, voffB);
    PG8_WAIT_V(6); PG8_BAR;
    for (;;) {
        const bool has_next = S.next(ui + 1, nxt);
        const char* nA = has_next ? nxt.a : cA; const char* nB = has_next ? nxt.b : cB;
        if (has_next) PG8_GFETCH(nxt);
        for (int t = 0; t < nt; t += 2) {
            const bool last = (t == nt - 2);
            const char* a1 = cA + (size_t)(t + 1) * kstep;
            const char* a2 = last ? nA : cA + (size_t)(t + 2) * kstep; const char* b2 = last ? nB : cB + (size_t)(t + 2) * kstep;
            const char* a3 = a2 + kstep; const char* b3 = b2 + kstep;
            if (last && has_next) S.a_ready(nxt);
            if (last) E.prefetch(pre, cur, wr, wc, fr, fq);
            PG8_LDB(B0, 0, 0); PG8_LDB(B1, 0, 1); PG8_SCHED; PG8_LDA(At, 0, 0); PG8_STA(PG8_SA(1, 1), a1, 1);
            if constexpr (GATHER) { if (last && has_next) PG8_GREAD(); }
            PG8_WAIT_V(8); PG8_WAIT_L(0); PG8_BAR; PG8_MMA(0, 0, At, B0); PG8_MMA(0, 1, At, B1); PG8_BAR; PG8_SCHED;
            if constexpr (!HALFM) PG8_LDA(At, 0, 1); PG8_STAGE(PG8_SB(0, 0), b2, voffB); PG8_STAGE(PG8_SB(0, 1), b2 + hstep, voffB); PG8_STA(PG8_SA(0, 0), a2, 0);
            PG8_WAIT_V(8); PG8_WAIT_L(0); PG8_BAR; if constexpr (!HALFM) { PG8_MMA(1, 0, At, B0); PG8_MMA(1, 1, At, B1); } PG8_BAR; PG8_SCHED;
            PG8_LDB(B0, 1, 0); PG8_LDB(B1, 1, 1); PG8_SCHED; PG8_LDA(At, 1, 0); PG8_STA(PG8_SA(0, 1), a2, 1);
            PG8_WAIT_V(8); PG8_WAIT_L(0); PG8_BAR; PG8_MMA(0, 0, At, B0); PG8_MMA(0, 1, At, B1); PG8_BAR; PG8_SCHED;
            if constexpr (!HALFM) PG8_LDA(At, 1, 1); PG8_STAGE(PG8_SB(1, 0), b3, voffB); PG8_STAGE(PG8_SB(1, 1), b3 + hstep, voffB); PG8_STA(PG8_SA(1, 0), a3, 0);
            PG8_WAIT_V(8); PG8_WAIT_L(0); PG8_BAR; if constexpr (!HALFM) { PG8_MMA(1, 0, At, B0); PG8_MMA(1, 1, At, B1); } PG8_BAR; PG8_SCHED;
        }
        if constexpr (ALIGN_EPI) { if (wr == 0) PG8_BAR; }
        { const int te = hw_lane();
          if constexpr (HALFM) E.half(acc, cur, wr, wc, te & 15, te >> 4, pre); else E(acc, cur, wr, wc, te & 15, te >> 4, pre); } S.done(cur);
        if (!has_next) break;
#pragma unroll
        for (int a = 0; a < 2; ++a)
#pragma unroll
            for (int b = 0; b < 2; ++b)
#pragma unroll
                for (int m = 0; m < 4; ++m)
#pragma unroll
                    for (int n = 0; n < 2; ++n) acc[a][b][m][n] = (f32x4){0.f, 0.f, 0.f, 0.f};
        cur = nxt; cA = nA; cB = nB; ++ui;
        if constexpr (ALIGN_EPI) { if (wr == 1) PG8_BAR; }
    }
    PG8_WAIT_V(0);
    if constexpr (!ALIGN_EPI) { if (wr == 0) PG8_BAR; }
    PG8_BAR;
#undef PG8_SA
#undef PG8_SB
#undef PG8_STAGE
#undef PG8_LDA
#undef PG8_STA
#undef PG8_GFETCH
#undef PG8_GREAD
#undef PG8_LDB
#undef PG8_MMA
#undef PG8_WAIT_V
#undef PG8_WAIT_L
#undef PG8_BAR
#undef PG8_SCHED
}
}

struct Args { const void* in[20]; float* out; unsigned char* ws; int ph_lo, ph_hi; };
struct Frame {
    LAS unsigned char* lds;
    int tid, lane, wave, G, bx;
    int c, GG;
    unsigned char* ws;
    unsigned* ctl;
};
#define WSP(T, off) ((T*)(F.ws + (off)))
#define B_XB WSP(bf16, WS_XB)
#define B_WIN WSP(bf16, WS_WIN)
#define B_WA WSP(bf16, WS_WA)
#define B_WB WSP(bf16, WS_WB)
#define B_WO WSP(bf16, WS_WO)
#define B_WGU8 WSP(unsigned char, WS_WGU)
#define B_WD8 WSP(unsigned char, WS_WD)
#define B_SGW WSP(bf16, WS_SGW)
#define B_CS WSP(float, WS_CS)
#define B_WRT WSP(bf16, WS_WRT)
#define B_X8 WSP(unsigned char, WS_X8)
#define B_WIN8 WSP(unsigned char, WS_WIN8)
#define B_VST WSP(float, WS_VST)
#define B_QB WSP(bf16, WS_QB)
#define B_KB WSP(bf16, WS_KB)
#define B_VB WSP(bf16, WS_VB)
#define B_ZB WSP(bf16, WS_ZB)
#define B_GT WSP(bf16, WS_GT)
#define B_OG WSP(bf16, WS_OG)
#define B_LSE WSP(float, WS_LSE)
#define B_OA WSP(bf16, WS_OA)
#define B_SGI WSP(bf16, WS_SGI)
#define B_MRG WSP(bf16, WS_MRG)
#define B_X1F WSP(bf16, WS_X1F)
#define B_X1Q WSP(unsigned char, WS_X1B)
#define B_MRG8 WSP(unsigned char, WS_X1B + 32 * MiB)
#define B_WO8 WSP(unsigned char, WS_WO)
#define B_LN1ST WSP(float, WS_VST)
#define B_X1H WSP(bf16, WS_MRG)
#define B_CNTWG WSP(int, WS_STOK)
#define B_TGATE WSP(float, WS_SGATE)
#define B_INV WSP(int, WS_INV)
#define B_RGATE WSP(float, WS_RGATE)
#define B_ROWTOK WSP(int, WS_STOK + 1 * MiB)
#define B_TPG WSP(int, WS_RGATE + 512 * 1024)
#define B_XS8 WSP(unsigned char, WS_XS)
#define B_HB8 WSP(unsigned char, WS_HB)
#define B_YB WSP(unsigned char, WS_YB)

__device__ __forceinline__ unsigned off_b(unsigned row, unsigned ch) { return 256u * row + 16u * (ch ^ (((row & 3) << 2) | ((row >> 2) & 3))); }
__device__ __forceinline__ unsigned tr_addr16(unsigned lane, unsigned c, unsigned ks, unsigned t) {
    const unsigned g = lane >> 4, q = (lane & 15) >> 2, p = lane & 3;
    return off_b(32 * ks + 8 * g + 4 * t + q, 2 * c + (p >> 1)) + 8 * (p & 1);
}
template <int OFF>
__device__ __forceinline__ bf16x8 tr_read2(unsigned a0, unsigned a1) {
    s16x4 lo, hi;
    asm volatile("ds_read_b64_tr_b16 %0, %2 offset:%4\n\tds_read_b64_tr_b16 %1, %3 offset:%4\n\ts_waitcnt lgkmcnt(0)" : "=&v"(lo), "=&v"(hi) : "v"(a0), "v"(a1), "i"(OFF) : "memory");
    bf16x8 r; r[0] = lo[0]; r[1] = lo[1]; r[2] = lo[2]; r[3] = lo[3]; r[4] = hi[0]; r[5] = hi[1]; r[6] = hi[2]; r[7] = hi[3]; return r;
}

template <int OFF>
__device__ __forceinline__ void tr_read16(const unsigned (&a)[8][2], bf16x8 (&f)[8]) {
    s16x4 r[16];
    asm volatile("ds_read_b64_tr_b16 %0, %16 offset:%32\n\tds_read_b64_tr_b16 %1, %17 offset:%32\n\tds_read_b64_tr_b16 %2, %18 offset:%32\n\tds_read_b64_tr_b16 %3, %19 offset:%32\n\t"
                 "ds_read_b64_tr_b16 %4, %20 offset:%32\n\tds_read_b64_tr_b16 %5, %21 offset:%32\n\tds_read_b64_tr_b16 %6, %22 offset:%32\n\tds_read_b64_tr_b16 %7, %23 offset:%32\n\t"
                 "ds_read_b64_tr_b16 %8, %24 offset:%32\n\tds_read_b64_tr_b16 %9, %25 offset:%32\n\tds_read_b64_tr_b16 %10, %26 offset:%32\n\tds_read_b64_tr_b16 %11, %27 offset:%32\n\t"
                 "ds_read_b64_tr_b16 %12, %28 offset:%32\n\tds_read_b64_tr_b16 %13, %29 offset:%32\n\tds_read_b64_tr_b16 %14, %30 offset:%32\n\tds_read_b64_tr_b16 %15, %31 offset:%32\n\ts_waitcnt lgkmcnt(0)"
                 : "=&v"(r[0]), "=&v"(r[1]), "=&v"(r[2]), "=&v"(r[3]), "=&v"(r[4]), "=&v"(r[5]), "=&v"(r[6]), "=&v"(r[7]), "=&v"(r[8]), "=&v"(r[9]), "=&v"(r[10]), "=&v"(r[11]), "=&v"(r[12]), "=&v"(r[13]), "=&v"(r[14]), "=&v"(r[15])
                 : "v"(a[0][0]), "v"(a[0][1]), "v"(a[1][0]), "v"(a[1][1]), "v"(a[2][0]), "v"(a[2][1]), "v"(a[3][0]), "v"(a[3][1]), "v"(a[4][0]), "v"(a[4][1]), "v"(a[5][0]), "v"(a[5][1]), "v"(a[6][0]), "v"(a[6][1]), "v"(a[7][0]), "v"(a[7][1]), "i"(OFF)
                 : "memory");
#pragma unroll
    for (int c = 0; c < 8; ++c) { bf16x8 t; t[0] = r[2 * c][0]; t[1] = r[2 * c][1]; t[2] = r[2 * c][2]; t[3] = r[2 * c][3]; t[4] = r[2 * c + 1][0]; t[5] = r[2 * c + 1][1]; t[6] = r[2 * c + 1][2]; t[7] = r[2 * c + 1][3]; f[c] = t; }
}

__device__ __forceinline__ void p0_transpose_item(const float* W, int K, int N, bf16* WT, int k0, int n0, int drow0, LAS float* scr, int lane) {
#pragma unroll 8
    for (int i = 0; i < 32; ++i) { const int kk = 2 * i + (lane >> 5); scr[kk * 33 + (lane & 31)] = W[(size_t)(k0 + kk) * N + n0 + (lane & 31)]; }
    asm volatile("s_waitcnt lgkmcnt(0)" ::: "memory");
    const int c = lane & 7;
#pragma unroll
    for (int j = 0; j < 4; ++j) { const int n = (lane >> 3) + 8 * j; const LAS float* s = scr + (8 * c) * 33 + n;
        u32x4 o; o.x = cvt_pk_bf16(s[0 * 33], s[1 * 33]); o.y = cvt_pk_bf16(s[2 * 33], s[3 * 33]); o.z = cvt_pk_bf16(s[4 * 33], s[5 * 33]); o.w = cvt_pk_bf16(s[6 * 33], s[7 * 33]);
        *(u32x4*)(WT + (size_t)(drow0 + n) * K + k0 + 8 * c) = o; }
    asm volatile("s_waitcnt lgkmcnt(0)" ::: "memory");
}
constexpr int N8E = NE * ((D / 128) * (2 * DE / 32) + (DE / 128) * (D / 32));
constexpr int N8Q = N8E + (D / 128) * ((3 * AW + 2 * D) / 32);
constexpr int N8 = N8Q + (D / 128) * (D / 32);
struct P0Item { const float* src; unsigned char* dst; int N, K; float scale; };
__device__ __forceinline__ void p0_item8_decode(const Args& args, Frame& F, int it, P0Item& I) {
    constexpr int I_GU1 = (D / 128) * (2 * DE / 32);
    constexpr int I_D1 = (DE / 128) * (D / 32);
    if (it < NE * I_GU1) { const int e = it / I_GU1, q = it % I_GU1, nb = 2 * DE / 32, n0 = 32 * (q % nb), k0 = 128 * (q / nb);
        const int bj = n0 / DE, rem = n0 % DE, drow0 = 256 * (rem / 128) + 128 * bj + (rem % 128);
        I.src = ((const float*)args.in[14]) + (size_t)e * D * 2 * DE + (size_t)k0 * (2 * DE) + n0; I.dst = B_WGU8 + (size_t)e * 2 * DE * D + (size_t)drow0 * D + k0; I.N = 2 * DE; I.K = D; I.scale = pg8::SC_WGU; }
    else if (it < NE * (I_GU1 + I_D1)) { const int r = it - NE * I_GU1; const int e = r / I_D1, q = r % I_D1, nb = D / 32, n0 = 32 * (q % nb), k0 = 128 * (q / nb);
        I.src = ((const float*)args.in[16]) + (size_t)e * DE * D + (size_t)k0 * D + n0; I.dst = B_WD8 + (size_t)e * D * DE + (size_t)n0 * DE + k0; I.N = D; I.K = DE; I.scale = pg8::SC_WD; }
    else if (it >= N8Q) { const int q = it - N8Q, nb = D / 32, n0 = 32 * (q % nb), k0 = 128 * (q / nb);
        I.src = ((const float*)args.in[9]) + (size_t)k0 * D + n0; I.dst = B_WO8 + (size_t)n0 * D + k0; I.N = D; I.K = D; I.scale = pg8::SC_WO; }
    else { const int q = it - NE * (I_GU1 + I_D1), nb = (3 * AW + 2 * D) / 32, r0 = 32 * (q % nb), k0 = 128 * (q / nb);
        const int n0 = r0 < 3 * AW ? r0 : r0 + 2 * SW;
        I.src = ((const float*)args.in[2]) + (size_t)k0 * INW + n0; I.dst = B_WIN8 + (size_t)r0 * D + k0; I.N = INW; I.K = D; I.scale = pg8::SC_WGU; }
}
__device__ __forceinline__ void p0_item8_load(const P0Item& I, int lane, f32x4 (&v)[4][4]) {
    const int c = lane & 7, r = lane >> 3;
    const float* p = I.src + (size_t)(4 * r) * I.N + 4 * c;
#pragma unroll
    for (int j = 0; j < 4; ++j)
#pragma unroll
        for (int i = 0; i < 4; ++i) v[j][i] = __builtin_nontemporal_load((const f32x4*)(p + (size_t)(32 * j + i) * I.N));
}
__device__ __forceinline__ void p0_item8_store(const P0Item& I, int lane, const f32x4 (&v)[4][4], LAS unsigned* scr) {
    const int c = lane & 7, r = lane >> 3; const float s = I.scale;
#pragma unroll
    for (int j = 0; j < 4; ++j)
#pragma unroll
        for (int m = 0; m < 4; ++m) scr[(4 * c + m) * 33 + r + 8 * j] = pg8::pk4_fp8(v[j][0][m] * s, v[j][1][m] * s, v[j][2][m] * s, v[j][3][m] * s);
    asm volatile("s_waitcnt lgkmcnt(0)" ::: "memory");
    const int ch = lane & 7;
#pragma unroll
    for (int jj = 0; jj < 4; ++jj) { const int n = (lane >> 3) + 8 * jj; const LAS unsigned* q = scr + n * 33 + 4 * ch;
        u32x4 o; o.x = q[0]; o.y = q[1]; o.z = q[2]; o.w = q[3];
        *(u32x4*)(I.dst + (size_t)n * I.K + 16 * ch) = o; }
    asm volatile("s_waitcnt lgkmcnt(0)" ::: "memory");
}
#ifndef BG_NB
#define BG_NB 120
#endif
#ifndef BG_F0
#define BG_F0 0
#endif
constexpr int BG_N0 = (int)((long)N8E * BG_F0 / 1000);
__device__ __forceinline__ void p0_items8(const Args& args, Frame& F, int lo, int hi, int gw, int NGW) {
    LAS unsigned* scr8 = (LAS unsigned*)(F.lds + F.wave * 16384);
    f32x4 va[4][4], vb[4][4], vc[4][4]; P0Item Ia, Ib, Ic;
    int it = lo + gw;
    if (it < hi) { p0_item8_decode(args, F, it, Ia); p0_item8_load(Ia, F.lane, va); }
    if (it + NGW < hi) { p0_item8_decode(args, F, it + NGW, Ib); p0_item8_load(Ib, F.lane, vb); }
    while (it < hi) {
        if (it + 2 * NGW < hi) { p0_item8_decode(args, F, it + 2 * NGW, Ic); p0_item8_load(Ic, F.lane, vc); }
        p0_item8_store(Ia, F.lane, va, scr8);
        it += NGW; if (it >= hi) break;
        if (it + 2 * NGW < hi) { p0_item8_decode(args, F, it + 2 * NGW, Ia); p0_item8_load(Ia, F.lane, va); }
        p0_item8_store(Ib, F.lane, vb, scr8);
        it += NGW; if (it >= hi) break;
        if (it + 2 * NGW < hi) { p0_item8_decode(args, F, it + 2 * NGW, Ib); p0_item8_load(Ib, F.lane, vb); }
        p0_item8_store(Ic, F.lane, vc, scr8);
        it += NGW;
    }
}
__device__ __forceinline__ void p0_convert(const Args& args, Frame& F) {
    LAS float* scr = (LAS float*)(F.lds + F.wave * 16384);
    const int gw = F.bx * 8 + F.wave, NGW = F.G * 8;
    constexpr int I_IN = (D / 64) * (2 * SW / 32), I_A = (AO / 64) * (D / 32), I_B = (SW / 64) * (D / 32);
    constexpr int NITEMS = I_IN + I_A + I_B;
    for (int it = gw; it < NITEMS; it += NGW) {
        int r = it;
        if (r < I_IN) { const int nb = 2 * SW / 32; p0_transpose_item(((const float*)args.in[2]), D, INW, B_WIN, 64 * (r / nb), 3 * AW + 32 * (r % nb), 32 * (r % nb), scr, F.lane); continue; } r -= I_IN;
        if (r < I_A) { const int nb = D / 32; p0_transpose_item(((const float*)args.in[3]), AO, D, B_WA, 64 * (r / nb), 32 * (r % nb), 32 * (r % nb), scr, F.lane); continue; } r -= I_A;
        { const int nb = D / 32; p0_transpose_item(((const float*)args.in[8]), SW, D, B_WB, 64 * (r / nb), 32 * (r % nb), 32 * (r % nb), scr, F.lane); }
    }
    p0_items8(args, F, 0, BG_N0, gw, NGW);
    p0_items8(args, F, N8E, N8, gw, NGW);
    const size_t gt = (size_t)F.bx * 512 + F.tid, NT = (size_t)F.G * 512;
    for (size_t i0 = gt; i0 < (size_t)S * D / 8; i0 += 4 * NT) {
        f32x4 a[4], b[4];
#pragma unroll
        for (int u = 0; u < 4; ++u) { const size_t i = i0 + u * NT; if (i < (size_t)S * D / 8) { a[u] = __builtin_nontemporal_load(((const f32x4*)((const float*)args.in[0])) + 2 * i); b[u] = __builtin_nontemporal_load(((const f32x4*)((const float*)args.in[0])) + 2 * i + 1); } }
#pragma unroll
        for (int u = 0; u < 4; ++u) { const size_t i = i0 + u * NT; if (i < (size_t)S * D / 8) {
            u32x4 w; w.x = cvt_pk_bf16(a[u][0], a[u][1]); w.y = cvt_pk_bf16(a[u][2], a[u][3]); w.z = cvt_pk_bf16(b[u][0], b[u][1]); w.w = cvt_pk_bf16(b[u][2], b[u][3]); ((u32x4*)B_XB)[i] = w;
            u32x2 w8; w8.x = pg8::pk4_fp8(pg8::clamp448(a[u][0] * pg8::SC_X1), pg8::clamp448(a[u][1] * pg8::SC_X1), pg8::clamp448(a[u][2] * pg8::SC_X1), pg8::clamp448(a[u][3] * pg8::SC_X1));
            w8.y = pg8::pk4_fp8(pg8::clamp448(b[u][0] * pg8::SC_X1), pg8::clamp448(b[u][1] * pg8::SC_X1), pg8::clamp448(b[u][2] * pg8::SC_X1), pg8::clamp448(b[u][3] * pg8::SC_X1)); ((u32x2*)B_X8)[i] = w8; } }
    }
    for (size_t i = gt; i < (size_t)MAXROWS; i += NT) B_ROWTOK[i] = 0;
    for (size_t i = gt; i < (size_t)8 * 128 * 128 / 8; i += NT) { const f32x4 a = ((const f32x4*)((const float*)args.in[6]))[2 * i], b = ((const f32x4*)((const float*)args.in[6]))[2 * i + 1];
        u32x4 w; w.x = cvt_pk_bf16(a[0], a[1]); w.y = cvt_pk_bf16(a[2], a[3]); w.z = cvt_pk_bf16(b[0], b[1]); w.w = cvt_pk_bf16(b[2], b[3]); ((u32x4*)B_SGW)[i] = w; }
    for (size_t i = gt; i < (size_t)NE * D; i += NT) { const int e = (int)(i >> 11), k = (int)(i & 2047);
        ((_Float16*)B_WRT)[i] = (_Float16)((const float*)args.in[12])[(size_t)k * NE + e]; }
    for (size_t i = gt; i < (size_t)S * 16; i += NT) { const int t = (int)(i >> 4), j = (int)(i & 15);
        const float invf = (float)exp2(-(double)j * (18.931568569324174 / 16.0));
        const float ang = (float)((const int*)args.in[1])[t] * invf; float sn, cn; sincosf(ang, &sn, &cn);
        B_CS[2 * i] = cn; B_CS[2 * i + 1] = sn; }
}

struct AttnGeom { int g, h, dsh, L, r, b, hcol, sj0; };
__device__ __forceinline__ void attn_geom(int unit, AttnGeom& A) {
    A.g = unit / 512; A.h = (unit >> 7) & 3; const int blk = unit & 127;
    A.dsh = 2 * A.g; A.L = S >> A.dsh; const int bpr = A.L >> 7;
    A.r = blk / bpr; A.b = blk % bpr; A.hcol = A.g * 512 + A.h * 128; A.sj0 = A.b * 128 - 64;
}
__device__ __forceinline__ void attn_dma(Frame& F, const bf16* base, LAS unsigned char* img, const AttnGeom& A) {
#pragma unroll
    for (int ii = 0; ii < 8; ++ii) {
        const int i = F.wave + 8 * ii, j = 4 * i + (F.lane >> 4), cp = F.lane & 15, ch = cp ^ (((j & 3) << 2) | ((j >> 2) & 3));
        int sj = A.sj0 + j; sj = sj < 0 ? 0 : (sj > A.L - 1 ? A.L - 1 : sj);
        const size_t tok = ((size_t)sj << A.dsh) + A.r;
        __builtin_amdgcn_global_load_lds((const unsigned*)(base + tok * AW + A.hcol + 8 * ch), (LAS unsigned*)(img + i * 1024), 16, 0, 0);
    }
}
__device__ __forceinline__ void attn_phase(Frame& F) {
    LAS unsigned char* Kimg = F.lds;
    LAS unsigned char* Vimg = F.lds + 65536;
    int unit = F.c; if (unit >= 1536) return;
    AttnGeom A; attn_geom(unit, A);
    attn_dma(F, B_KB, Kimg, A); attn_dma(F, B_VB, Vimg, A);
    for (;;) {
        const int un = unit + F.GG; const bool hn = un < 1536; AttnGeom An = A; if (hn) attn_geom(un, An);
        const int g = A.g, h = A.h, dsh = A.dsh, L = A.L, r = A.r, b = A.b, hcol = A.hcol, sj0 = A.sj0;
        const int jmin = sj0 < 0 ? -sj0 : 0, jmax = (L - sj0) < 256 ? (L - sj0) : 256;
        const int w = F.wave, lane = F.lane, fr = lane & 15, fq = lane >> 4;
        const int iq = 16 * w + fr;
        const size_t tq = ((size_t)(b * 128 + iq) << dsh) + r;
        bf16x8 Qf[4];
#pragma unroll
        for (int ks = 0; ks < 4; ++ks) Qf[ks] = *(const bf16x8*)(B_QB + tq * AW + hcol + 32 * ks + 8 * fq);
        asm volatile("s_waitcnt vmcnt(0)" ::: "memory"); __builtin_amdgcn_s_barrier(); asm volatile("" ::: "memory");
        const int sb0 = w >> 1;
        f32x4 Sx[5][2];
        const int krow = 8 * (fr >> 2) + (fr & 3);
        const LAS unsigned char* Kw = Kimg + sb0 * 8192;
        unsigned kaddr[2][4];
#pragma unroll
        for (int hf = 0; hf < 2; ++hf)
#pragma unroll
            for (int ks = 0; ks < 4; ++ks) kaddr[hf][ks] = off_b(krow + 4 * hf, 4 * ks + fq);
#pragma unroll
        for (int sbi = 0; sbi < 5; ++sbi)
#pragma unroll
            for (int hf = 0; hf < 2; ++hf) {
                f32x4 a = (f32x4){0.f, 0.f, 0.f, 0.f};
#pragma unroll
                for (int ks = 0; ks < 4; ++ks) {
                    const bf16x8 kf = *(const LAS bf16x8*)(Kw + kaddr[hf][ks] + sbi * 8192);
                    a = __builtin_amdgcn_mfma_f32_16x16x32_bf16(kf, Qf[ks], a, 0, 0, 0);
                }
                Sx[sbi][hf] = a;
            }
        asm volatile("s_waitcnt lgkmcnt(0)" ::: "memory"); __builtin_amdgcn_s_barrier(); asm volatile("" ::: "memory");
        if (hn) attn_dma(F, B_KB, Kimg, An);
        const float sc = 0.08838834764831845f;
        float mx = -3.0e38f;
#pragma unroll
        for (int sbi = 0; sbi < 5; ++sbi)
#pragma unroll
            for (int hf = 0; hf < 2; ++hf)
#pragma unroll
                for (int j = 0; j < 4; ++j) {
                    const int kj = 32 * (sb0 + sbi) + 8 * fq + 4 * hf + j;
                    const bool ok = (kj >= iq) && (kj <= iq + 128) && (kj >= jmin) && (kj < jmax);
                    const float s = ok ? Sx[sbi][hf][j] * sc : -1.0e30f;
                    Sx[sbi][hf][j] = s; mx = fmaxf(mx, s);
                }
        mx = fmaxf(mx, __shfl_xor(mx, 16)); mx = fmaxf(mx, __shfl_xor(mx, 32));
        float den = 0.f;
#pragma unroll
        for (int sbi = 0; sbi < 5; ++sbi)
#pragma unroll
            for (int hf = 0; hf < 2; ++hf)
#pragma unroll
                for (int j = 0; j < 4; ++j) { const float p = fast_exp2((Sx[sbi][hf][j] - mx) * 1.44269504089f); Sx[sbi][hf][j] = p; den += p; }
        den += __shfl_xor(den, 16); den += __shfl_xor(den, 32);
        bf16x8 Pf[5];
#pragma unroll
        for (int sbi = 0; sbi < 5; ++sbi) {
            u32x4 w4; w4.x = cvt_pk_bf16(Sx[sbi][0][0], Sx[sbi][0][1]); w4.y = cvt_pk_bf16(Sx[sbi][0][2], Sx[sbi][0][3]);
            w4.z = cvt_pk_bf16(Sx[sbi][1][0], Sx[sbi][1][1]); w4.w = cvt_pk_bf16(Sx[sbi][1][2], Sx[sbi][1][3]);
            Pf[sbi] = __builtin_bit_cast(bf16x8, w4);
        }
        f32x4 O[8];
#pragma unroll
        for (int c = 0; c < 8; ++c) O[c] = (f32x4){0.f, 0.f, 0.f, 0.f};
        const unsigned vbase = (unsigned)(size_t)Vimg + (unsigned)sb0 * 8192u;
        unsigned vaddr[8][2];
#pragma unroll
        for (int c = 0; c < 8; ++c) { vaddr[c][0] = vbase + tr_addr16(lane, c, 0, 0); vaddr[c][1] = vbase + tr_addr16(lane, c, 0, 1); }
#define PV_STEP(sbi) do { bf16x8 vf[8]; tr_read16<(sbi) * 8192>(vaddr, vf); _Pragma("unroll") for (int c = 0; c < 8; ++c) \
            O[c] = __builtin_amdgcn_mfma_f32_16x16x32_bf16(vf[c], Pf[sbi], O[c], 0, 0, 0); } while (0)
        PV_STEP(0); PV_STEP(1); PV_STEP(2); PV_STEP(3); PV_STEP(4);
#undef PV_STEP
        const float rden = 1.0f / den;
        bf16* op = B_OG + ((size_t)g * S + tq) * AO + h * 128 + 4 * fq;
#pragma unroll
        for (int c = 0; c < 8; ++c) { const f32x4 o = O[c] * rden; u32x2 w2; w2.x = cvt_pk_bf16(o[0], o[1]); w2.y = cvt_pk_bf16(o[2], o[3]); *(u32x2*)(op + 16 * c) = w2; }
        asm volatile("s_waitcnt lgkmcnt(0)" ::: "memory"); __builtin_amdgcn_s_barrier(); asm volatile("" ::: "memory");
        if (hn) attn_dma(F, B_VB, Vimg, An);
        if (fq == 0) B_LSE[((size_t)g * S + tq) * 4 + h] = mx + __logf(den);
        if (!hn) break;
        unit = un; A = An;
    }
    asm volatile("s_waitcnt vmcnt(0)" ::: "memory"); __syncthreads();
}
__device__ __forceinline__ void sgu_stats(Frame& F) {
    const int gw = F.c * 8 + F.wave, NGW = F.GG * 8;
    for (int tb = gw; tb < S; tb += 4 * NGW) {
        u32x4 a[4], b[4];
#pragma unroll
        for (int i = 0; i < 4; ++i) { const int t = tb + i * NGW; const u32x4* p = (const u32x4*)(B_ZB + (size_t)(t < S ? t : 0) * 2048 + SW + 16 * F.lane); a[i] = p[0]; b[i] = p[1]; }
#pragma unroll
        for (int i = 0; i < 4; ++i) {
            const int t = tb + i * NGW;
            float v[16] = {bflo(a[i].x), bfhi(a[i].x), bflo(a[i].y), bfhi(a[i].y), bflo(a[i].z), bfhi(a[i].z), bflo(a[i].w), bfhi(a[i].w), bflo(b[i].x), bfhi(b[i].x), bflo(b[i].y), bfhi(b[i].y), bflo(b[i].z), bfhi(b[i].z), bflo(b[i].w), bfhi(b[i].w)};
            float s = 0.f;
#pragma unroll
            for (int k = 0; k < 16; ++k) s += v[k];
            const float mean = wave_sum(s) * (1.0f / SW);
            float q = 0.f;
#pragma unroll
            for (int k = 0; k < 16; ++k) { const float d = v[k] - mean; q += d * d; }
            const float rstd = 1.0f / sqrtf(wave_sum(q) * (1.0f / SW) + LN_EPS);
            if (F.lane == 0 && t < S) { B_VST[2 * t] = mean; B_VST[2 * t + 1] = rstd; }
        }
    }
}
__device__ __forceinline__ void sgu_unit(const Args& args, Frame& F, int unit) {
    const int c = unit >> 3, g = unit & 7, t0 = 128 * c;
    const int w = F.wave, lane = F.lane, fr = lane & 15, fq = lane >> 4;
    LAS unsigned char* Vimg = F.lds;
#pragma unroll
    for (int i = 0; i < 4; ++i) {
        const int q = F.tid + 512 * i, s = q >> 4, ch = q & 15;
        const u32x4 a = *(const u32x4*)(B_ZB + (size_t)(t0 + s) * 2048 + SW + 128 * g + 8 * ch);
        const f32x2 ms = *(const f32x2*)(B_VST + 2 * (t0 + s)); const float mean = ms.x, rstd = ms.y;
        const float* gp = ((const float*)args.in[4]) + 128 * g + 8 * ch; const float* bp = ((const float*)args.in[5]) + 128 * g + 8 * ch;
        const f32x4 g0 = *(const f32x4*)gp, g1 = *(const f32x4*)(gp + 4), b0 = *(const f32x4*)bp, b1 = *(const f32x4*)(bp + 4);
        float v[8] = {bflo(a.x), bfhi(a.x), bflo(a.y), bfhi(a.y), bflo(a.z), bfhi(a.z), bflo(a.w), bfhi(a.w)};
#pragma unroll
        for (int e = 0; e < 8; ++e) v[e] = (v[e] - mean) * rstd * (e < 4 ? g0[e & 3] : g1[e & 3]) + (e < 4 ? b0[e & 3] : b1[e & 3]);
        u32x4 o; o.x = cvt_pk_bf16(v[0], v[1]); o.y = cvt_pk_bf16(v[2], v[3]); o.z = cvt_pk_bf16(v[4], v[5]); o.w = cvt_pk_bf16(v[6], v[7]);
        *(LAS u32x4*)(Vimg + off_b(s, ch)) = o;
    }
    bf16x8 Wf[4];
#pragma unroll
    for (int ks = 0; ks < 4; ++ks) Wf[ks] = *(const bf16x8*)(B_SGW + ((size_t)(g * 128 + 16 * w + fr)) * 128 + 32 * ks + 8 * fq);
    __syncthreads();
    const unsigned vbase = (unsigned)(size_t)Vimg;
    const int t = t0 + 16 * w + fr;
    const float bias = ((const float*)args.in[7])[g * 128 + 16 * w + fr];
#pragma unroll
    for (int cb = 0; cb < 8; ++cb) {
        f32x4 a = (f32x4){0.f, 0.f, 0.f, 0.f};
        const unsigned a0 = vbase + tr_addr16(lane, cb, 0, 0), a1 = vbase + tr_addr16(lane, cb, 0, 1);
        a = __builtin_amdgcn_mfma_f32_16x16x32_bf16(tr_read2<0>(a0, a1), Wf[0], a, 0, 0, 0);
        a = __builtin_amdgcn_mfma_f32_16x16x32_bf16(tr_read2<8192>(a0, a1), Wf[1], a, 0, 0, 0);
        a = __builtin_amdgcn_mfma_f32_16x16x32_bf16(tr_read2<16384>(a0, a1), Wf[2], a, 0, 0, 0);
        a = __builtin_amdgcn_mfma_f32_16x16x32_bf16(tr_read2<24576>(a0, a1), Wf[3], a, 0, 0, 0);
        const int chn = 128 * g + 16 * cb + 4 * fq;
        const u32x2 uu = *(const u32x2*)(B_ZB + (size_t)t * 2048 + chn);
        u32x2 o; o.x = cvt_pk_bf16(bflo(uu.x) * (a[0] + bias), bfhi(uu.x) * (a[1] + bias)); o.y = cvt_pk_bf16(bflo(uu.y) * (a[2] + bias), bfhi(uu.y) * (a[3] + bias));
        *(u32x2*)(B_SGI + (size_t)t * SW + chn) = o;
    }
    __syncthreads();
}

__device__ __forceinline__ void p3_combine(Frame& F) {
    const size_t gt = (size_t)F.c * 512 + F.tid, NT = (size_t)F.GG * 512;
    for (size_t i = gt; i < (size_t)S * AO / 8; i += NT) {
        const int t = (int)(i >> 6), c8 = (int)(i & 63), h = c8 >> 4;
        const float l0 = B_LSE[((size_t)0 * S + t) * 4 + h], l1 = B_LSE[((size_t)1 * S + t) * 4 + h], l2 = B_LSE[((size_t)2 * S + t) * 4 + h];
        const float m = fmaxf(l0, fmaxf(l1, l2));
        float w0 = __expf(l0 - m), w1 = __expf(l1 - m), w2 = __expf(l2 - m); const float rs = 1.0f / (w0 + w1 + w2); w0 *= rs; w1 *= rs; w2 *= rs;
        const u32x4 q0 = *(const u32x4*)(B_OG + ((size_t)0 * S + t) * AO + 8 * c8), q1 = *(const u32x4*)(B_OG + ((size_t)1 * S + t) * AO + 8 * c8), q2 = *(const u32x4*)(B_OG + ((size_t)2 * S + t) * AO + 8 * c8);
        const f32x4 a = (f32x4){bflo(q0.x), bfhi(q0.x), bflo(q0.y), bfhi(q0.y)} * w0 + (f32x4){bflo(q1.x), bfhi(q1.x), bflo(q1.y), bfhi(q1.y)} * w1 + (f32x4){bflo(q2.x), bfhi(q2.x), bflo(q2.y), bfhi(q2.y)} * w2;
        const f32x4 b = (f32x4){bflo(q0.z), bfhi(q0.z), bflo(q0.w), bfhi(q0.w)} * w0 + (f32x4){bflo(q1.z), bfhi(q1.z), bflo(q1.w), bfhi(q1.w)} * w1 + (f32x4){bflo(q2.z), bfhi(q2.z), bflo(q2.w), bfhi(q2.w)} * w2;
        u32x4 o; o.x = cvt_pk_bf16(a[0], a[1]); o.y = cvt_pk_bf16(a[2], a[3]); o.z = cvt_pk_bf16(b[0], b[1]); o.w = cvt_pk_bf16(b[2], b[3]);
        ((u32x4*)B_OA)[i] = o;
    }
}

__device__ __forceinline__ void p6_ln_router(const Args& args, Frame& F) {
    LAS float* xl = (LAS float*)F.lds;
    LAS float* part = (LAS float*)(F.lds + LDS_PART);
    LAS float* lg = (LAS float*)(F.lds + LDS_MISC + MISC_LG);
    LAS float* sel = lg + 512;
    LAS int* lcnt = (LAS int*)(F.lds + LDS_MISC + MISC_LC);
    const int fr = F.lane & 15, fq = F.lane >> 4;
    if (F.tid < 32) lcnt[F.tid] = 0;
    __syncthreads();
    h16x8 Bw[8][2];
    {   const _Float16* wh = (const _Float16*)B_WRT + (size_t)fr * D + 256 * F.wave + 8 * fq;
#pragma unroll
        for (int ks = 0; ks < 8; ++ks)
#pragma unroll
            for (int nb = 0; nb < 2; ++nb) Bw[ks][nb] = *(const h16x8*)(wh + (size_t)(16 * nb) * D + 32 * ks); }
    const float brt = ((const float*)args.in[13])[F.tid & 31];
    u32x4 raw[2][4];
    int it = F.c;
    if (it < S / 16) {
#pragma unroll
        for (int rr = 0; rr < 2; ++rr) { const u32x4* xp = (const u32x4*)(B_X1F + (size_t)(16 * it + 2 * F.wave + rr) * D) + F.lane;
#pragma unroll
            for (int j = 0; j < 4; ++j) raw[rr][j] = xp[64 * j]; }
    }
    for (; it < S / 16; it += F.GG) {
        const int t0 = 16 * it;
#pragma unroll
        for (int rr = 0; rr < 2; ++rr) {
            const int rl = 2 * F.wave + rr; const size_t row = (size_t)(t0 + rl);
            f32x4 v[4][2];
#pragma unroll
            for (int j = 0; j < 4; ++j) { const u32x4 r4 = raw[rr][j]; v[j][0] = (f32x4){bflo(r4.x), bfhi(r4.x), bflo(r4.y), bfhi(r4.y)}; v[j][1] = (f32x4){bflo(r4.z), bfhi(r4.z), bflo(r4.w), bfhi(r4.w)}; }
            float s = 0.f;
#pragma unroll
            for (int j = 0; j < 4; ++j)
#pragma unroll
                for (int hh = 0; hh < 2; ++hh) s += (v[j][hh][0] + v[j][hh][1]) + (v[j][hh][2] + v[j][hh][3]);
            const float mean = wave_sum(s) * (1.0f / D); float q = 0.f;
#pragma unroll
            for (int j = 0; j < 4; ++j)
#pragma unroll
                for (int hh = 0; hh < 2; ++hh) { v[j][hh] = v[j][hh] - mean; q += (v[j][hh][0] * v[j][hh][0] + v[j][hh][1] * v[j][hh][1]) + (v[j][hh][2] * v[j][hh][2] + v[j][hh][3] * v[j][hh][3]); }
            const float rstd = 1.0f / sqrtf(wave_sum(q) * (1.0f / D) + LN_EPS);
            if (F.lane == 0) *(f32x2*)(B_LN1ST + 2 * row) = (f32x2){mean, rstd};
#pragma unroll
            for (int j = 0; j < 4; ++j) {
                const int col = 8 * F.lane + 512 * j;
                const float* gp = ((const float*)args.in[10]) + col; const float* bp = ((const float*)args.in[11]) + col;
                const f32x4 y0 = v[j][0] * rstd * *(const f32x4*)gp + *(const f32x4*)bp, y1 = v[j][1] * rstd * *(const f32x4*)(gp + 4) + *(const f32x4*)(bp + 4);
                { u32x2 x8; x8.x = pg8::pk4_fp8(pg8::clamp448(y0[0] * pg8::SC_X1), pg8::clamp448(y0[1] * pg8::SC_X1), pg8::clamp448(y0[2] * pg8::SC_X1), pg8::clamp448(y0[3] * pg8::SC_X1));
                  x8.y = pg8::pk4_fp8(pg8::clamp448(y1[0] * pg8::SC_X1), pg8::clamp448(y1[1] * pg8::SC_X1), pg8::clamp448(y1[2] * pg8::SC_X1), pg8::clamp448(y1[3] * pg8::SC_X1));
                  *(u32x2*)(B_X1Q + row * D + col) = x8; }
                *(LAS f32x4*)(xl + rl * XLP + col) = y0; *(LAS f32x4*)(xl + rl * XLP + col + 4) = y1;
            }
        }
        __syncthreads();
        {
            f32x4 acc[2] = {(f32x4){0.f, 0.f, 0.f, 0.f}, (f32x4){0.f, 0.f, 0.f, 0.f}};
            const LAS float* xr = xl + fr * XLP + 256 * F.wave + 8 * fq;
#pragma unroll
            for (int ks = 0; ks < 8; ++ks) {
                const f32x4 a0 = *(const LAS f32x4*)(xr + 32 * ks), a1 = *(const LAS f32x4*)(xr + 32 * ks + 4);
                u32x4 hw;
                hw.x = __builtin_bit_cast(unsigned, __builtin_amdgcn_cvt_pkrtz(a0[0], a0[1])); hw.y = __builtin_bit_cast(unsigned, __builtin_amdgcn_cvt_pkrtz(a0[2], a0[3]));
                hw.z = __builtin_bit_cast(unsigned, __builtin_amdgcn_cvt_pkrtz(a1[0], a1[1])); hw.w = __builtin_bit_cast(unsigned, __builtin_amdgcn_cvt_pkrtz(a1[2], a1[3]));
                const h16x8 Ah = __builtin_bit_cast(h16x8, hw);
#pragma unroll
                for (int nb = 0; nb < 2; ++nb) acc[nb] = __builtin_amdgcn_mfma_f32_16x16x32_f16(Ah, Bw[ks][nb], acc[nb], 0, 0, 0);
            }
#pragma unroll
            for (int nb = 0; nb < 2; ++nb)
#pragma unroll
                for (int j = 0; j < 4; ++j) part[(F.wave * 16 + 4 * fq + j) * 32 + 16 * nb + fr] = acc[nb][j];
        }
        {   const int itn = it + F.GG;
            if (itn < S / 16) {
#pragma unroll
                for (int rr = 0; rr < 2; ++rr) { const u32x4* xp = (const u32x4*)(B_X1F + (size_t)(16 * itn + 2 * F.wave + rr) * D) + F.lane;
#pragma unroll
                    for (int j = 0; j < 4; ++j) raw[rr][j] = xp[64 * j]; }
            } }
        __syncthreads();
        {
            const int tl = F.tid >> 5, e = F.tid & 31, t = t0 + tl; float lgt = brt;
#pragma unroll
            for (int w8 = 0; w8 < 8; ++w8) lgt += part[(w8 * 16 + tl) * 32 + e];
            lg[tl * 32 + e] = lgt;
            asm volatile("s_waitcnt lgkmcnt(0)" ::: "memory");
            int rank = 0;
#pragma unroll
            for (int q4 = 0; q4 < 8; ++q4) { const f32x4 o = *(const LAS f32x4*)(lg + tl * 32 + 4 * q4);
#pragma unroll
                for (int j = 0; j < 4; ++j) { const int e2 = 4 * q4 + j; rank += (o[j] > lgt || (o[j] == lgt && e2 < e)) ? 1 : 0; } }
            if (rank < 4) sel[tl * 4 + rank] = lgt;
            asm volatile("s_waitcnt lgkmcnt(0)" ::: "memory");
            if (rank < 4) {
                const f32x4 sv = *(const LAS f32x4*)(sel + tl * 4);
                const float den = 1.0f + __expf(sv[1] - sv[0]) + __expf(sv[2] - sv[0]) + __expf(sv[3] - sv[0]);
                const int lrank = __hip_atomic_fetch_add(lcnt + e, 1, __ATOMIC_RELAXED, __HIP_MEMORY_SCOPE_WORKGROUP);
                B_TGATE[t * 4 + rank] = __expf(lgt - sv[0]) / den;
                B_INV[t * 4 + rank] = (e << 16) | lrank;
            }
        }
        __syncthreads();
    }
    if (F.tid < 32) B_CNTWG[F.c * 32 + F.tid] = lcnt[F.tid];
}
__device__ __forceinline__ void compute_tp(Frame& F) {
    LAS int* tp = (LAS int*)(F.lds + LDS_MISC + MISC_TP); LAS int* cnt = (LAS int*)(F.lds + LDS_MISC + MISC_CNT); LAS int* base = (LAS int*)(F.lds + LDS_MISC + MISC_BASE);
    LAS int* part = (LAS int*)(F.lds + LDS_MISC + MISC_PART);
    {   const int e = F.tid & 31, p = F.tid >> 5, per = (F.GG + 15) >> 4; int tot = 0, pre = 0;
        for (int i = 0; i < per; ++i) { const int wg = p * per + i; if (wg < F.GG) { const int c = B_CNTWG[wg * 32 + e]; tot += c; pre += (wg < F.c) ? c : 0; } }
        part[p * 32 + e] = tot; part[512 + p * 32 + e] = pre; }
    __syncthreads();
    if (F.tid < 32) { int tot = 0, pre = 0;
#pragma unroll
        for (int p = 0; p < 16; ++p) { tot += part[p * 32 + F.tid]; pre += part[512 + p * 32 + F.tid]; }
        cnt[F.tid] = tot; base[F.tid] = pre; }
    __syncthreads();
    if (F.tid == 0) { int acc = 0; tp[0] = 0; for (int e = 0; e < NE; ++e) { acc += (cnt[e] + 255) >> 8; tp[e + 1] = acc; } }
    __syncthreads();
}
__device__ __forceinline__ void load_tp(Frame& F) {
    LAS int* tp = (LAS int*)(F.lds + LDS_MISC + MISC_TP); LAS int* cnt = (LAS int*)(F.lds + LDS_MISC + MISC_CNT);
    if (F.tid < 33) tp[F.tid] = B_TPG[F.tid];
    if (F.tid >= 64 && F.tid < 96) cnt[F.tid - 64] = B_TPG[33 + F.tid - 64];
    __syncthreads();
}
__device__ __forceinline__ void p7_scatter(Frame& F) {
    const LAS int* tp = (const LAS int*)(F.lds + LDS_MISC + MISC_TP); const LAS int* base = (const LAS int*)(F.lds + LDS_MISC + MISC_BASE);
    for (int q = F.tid; ; q += 512) {
        const int it = F.c + (q >> 6) * F.GG; if (it >= S / 16) break;
        const int i = (16 * it) * 4 + (q & 63), es = B_INV[i], e = es >> 16;
        const int R = 256 * tp[e] + base[e] + (es & 0xffff);
        B_ROWTOK[R] = i >> 2; B_RGATE[R] = B_TGATE[i]; B_INV[i] = R;
    }
}
__device__ __forceinline__ f32x4 fp8x4_to_f32(unsigned w) { const f32x2 lo = __builtin_amdgcn_cvt_pk_f32_fp8((int)w, false), hi = __builtin_amdgcn_cvt_pk_f32_fp8((int)w, true); return (f32x4){lo.x, lo.y, hi.x, hi.y}; }
__device__ __forceinline__ void p10_final(const Args& args, Frame& F) {
    const int gw = F.c * 8 + F.wave, NGW = F.GG * 8;
    int Rn[4] = {0, 0, 0, 0};
    u32x4 ya[2][4], xh[2][2]; f32x2 st1 = (f32x2){0.f, 1.f};
    LAS float* gl = (LAS float*)F.lds; LAS float* bl = gl + D; LAS float* g2l = bl + D; LAS float* b2l = g2l + D;
    for (int i = F.tid; i < D; i += 512) { gl[i] = ((const float*)args.in[10])[i]; bl[i] = ALPHA * ((const float*)args.in[11])[i]; g2l[i] = ((const float*)args.in[18])[i]; b2l[i] = ((const float*)args.in[19])[i]; }
    __syncthreads();
#define P10_ROWS(tt) do { _Pragma("unroll") for (int k = 0; k < 4; ++k) Rn[k] = B_INV[(tt) * 4 + k]; } while (0)
#define P10_LOAD(tt) do { const u32x4* xp_ = (const u32x4*)(B_X1F + (size_t)(tt) * D) + 2 * F.lane; st1 = *(const f32x2*)(B_LN1ST + 2 * (size_t)(tt)); \
        _Pragma("unroll") for (int j = 0; j < 2; ++j) { _Pragma("unroll") for (int k = 0; k < 4; ++k) ya[j][k] = *(const u32x4*)(B_YB + (size_t)Rn[k] * D + 16 * F.lane + 1024 * j); \
            xh[j][0] = xp_[128 * j]; xh[j][1] = xp_[128 * j + 1]; } } while (0)
    if (gw < S) { P10_ROWS(gw); P10_LOAD(gw); if (gw + NGW < S) P10_ROWS(gw + NGW); }
    for (int t = gw; t < S; t += NGW) {
        f32x4 v[8]; float s = 0.f;
        const float a1 = ALPHA * st1.y, c1 = -st1.x * a1;
        int lo16 = 16 * F.lane; asm volatile("" : "+v"(lo16));
#pragma unroll
        for (int j = 0; j < 2; ++j) {
            const LAS float* gq = gl + lo16 + 1024 * j; const LAS float* bq = bl + lo16 + 1024 * j;
            f32x4 ys[4];
#pragma unroll
            for (int w = 0; w < 4; ++w) ys[w] = (f32x4){0.f, 0.f, 0.f, 0.f};
#pragma unroll
            for (int k = 0; k < 4; ++k) { const u32x4 a = ya[j][k]; ys[0] += fp8x4_to_f32(a.x); ys[1] += fp8x4_to_f32(a.y); ys[2] += fp8x4_to_f32(a.z); ys[3] += fp8x4_to_f32(a.w); }
            const u32x4 x0 = xh[j][0], x1 = xh[j][1];
            const f32x4 xr[4] = {(f32x4){bflo(x0.x), bfhi(x0.x), bflo(x0.y), bfhi(x0.y)}, (f32x4){bflo(x0.z), bfhi(x0.z), bflo(x0.w), bfhi(x0.w)},
                                 (f32x4){bflo(x1.x), bfhi(x1.x), bflo(x1.y), bfhi(x1.y)}, (f32x4){bflo(x1.z), bfhi(x1.z), bflo(x1.w), bfhi(x1.w)}};
#pragma unroll
            for (int w = 0; w < 4; ++w) {
                const f32x4 vv = (xr[w] * a1 + c1) * *(const LAS f32x4*)(gq + 4 * w) + (*(const LAS f32x4*)(bq + 4 * w) + ys[w] * (1.0f / pg8::SC_Y));
                v[4 * j + w] = vv; s += (vv[0] + vv[1]) + (vv[2] + vv[3]); }
        }
        if (t + NGW < S) { P10_LOAD(t + NGW); if (t + 2 * NGW < S) P10_ROWS(t + 2 * NGW); }
        const float mean = wave_sum(s) * (1.0f / D); float q = 0.f;
#pragma unroll
        for (int j = 0; j < 8; ++j) { v[j] = v[j] - mean; q += (v[j][0] * v[j][0] + v[j][1] * v[j][1]) + (v[j][2] * v[j][2] + v[j][3] * v[j][3]); }
        const float rstd = 1.0f / sqrtf(wave_sum(q) * (1.0f / D) + LN_EPS);
        float* op = args.out + (size_t)t * D;
#pragma unroll
        for (int j = 0; j < 2; ++j)
#pragma unroll
            for (int w = 0; w < 4; ++w) { const int col = 16 * F.lane + 1024 * j + 4 * w, lc = lo16 + 1024 * j + 4 * w;
                *(f32x4*)(op + col) = v[4 * j + w] * rstd * *(const LAS f32x4*)(g2l + lc) + *(const LAS f32x4*)(b2l + lc); }
    }
#undef P10_ROWS
#undef P10_LOAD
}

constexpr int N_PHASES = 11;
__global__ void __launch_bounds__(512, 2) mk_fwd(Args args) {
    extern __shared__ __attribute__((aligned(16))) unsigned char lds_raw[];
    Frame F;
    F.lds = (LAS unsigned char*)lds_raw;
    const int tid0 = threadIdx.x;
    F.tid = tid0; F.lane = tid0 & 63; F.wave = __builtin_amdgcn_readfirstlane(tid0 >> 6); F.G = gridDim.x; F.bx = blockIdx.x; F.c = F.bx; F.GG = F.G;
    unsigned char* ws = args.ws;
    F.ws = ws; F.ctl = (unsigned*)(ws + WS_CTL);
    for (int u = tid0; u < (LDS_BYTES - LDS_MISC) / 4; u += 512) ((LAS unsigned*)(F.lds + LDS_MISC))[u] = 0u;
    __syncthreads();
    const int lo = args.ph_lo, hi = args.ph_hi;
    const bool one = (hi - lo) > 1;
    XcdBarrier bar; bar.bar = F.ctl + CW_BAR; bar.x = 0; bar.st = (volatile LAS unsigned*)(F.lds + LDS_MISC + MISC_BAR);
    if (one) bar = xcd_barrier_post(F.ctl + CW_BAR, (volatile LAS unsigned*)(F.lds + LDS_MISC + MISC_BAR), tid0 == 0);
#ifndef PH_MASK
#define PH_MASK 0x7ff
#endif
#define IN(k) (((PH_MASK >> (k)) & 1) && lo <= (k) && (k) < hi)
#define SEAM(k) do { if (IN(k) && IN((k) + 1)) xcd_barrier(bar, F.wave == 0 && hw_lane() == 0); } while (0)
#define RELANE() do { F.lane = hw_lane(); F.tid = F.wave * 64 + F.lane; } while (0)
    const LAS int* tp = (const LAS int*)(F.lds + LDS_MISC + MISC_TP);

    const int GF = F.G - BG_NB; const bool bgw = (BG_NB > 0) && (F.bx >= GF);
    const int bgi = (F.bx - GF) * 8 + F.wave, bgn = BG_NB * 8;
    if (IN(0)) { RELANE(); p0_convert(args, F); }
    SEAM(0);
    if (IN(1)) { RELANE();
        if (bgw) { p0_items8(args, F, BG_N0, N8E, bgi, bgn); __syncthreads(); }
        { pg8::QueueOrder So; So.init(B_X8, B_WIN8, S, 3 * AW + 2 * D, D, F.ctl + CW_Q1, (volatile LAS unsigned*)(F.lds + LDS_MISC + MISC_QS), (int)xb_xcc_id(), F.wave);
          pg8::EpiIn E{B_QB, B_KB, B_VB, B_ZB, B_GT, B_CS, 0, 1.0f / (pg8::SC_X1 * pg8::SC_WGU)};
          pg8::gemm_phase<pg8::EpiIn, pg8::QueueOrder, true>(F.lds, D, So, E, F.wave); }
        { pg8::DenseOrder So; So.init(B_XB, B_WIN, S, 2 * SW, 2 * D, F.G, F.G - 1 - F.bx);
          pg8::EpiIn E{B_QB, B_KB, B_VB, B_ZB, B_GT, B_CS, 18, 1.0f};
          pg8::gemm_phase<pg8::EpiIn, pg8::DenseOrder>(F.lds, 2 * D, So, E, F.wave); }
    }
    SEAM(1);
    if (IN(2)) { RELANE(); attn_phase(F); sgu_stats(F); }
    SEAM(2);
    if (IN(3)) { RELANE(); for (int u = F.c; u < 1024; u += F.GG) sgu_unit(args, F, u); p3_combine(F); }
    SEAM(3);
    if (IN(4)) { RELANE();
        { pg8::DenseOrder So; So.init(B_OA, B_WA, S, D, 2 * AO, F.G, F.bx); pg8::EpiGateT<false> E{B_MRG, B_GT, 0, 0, nullptr};
          pg8::gemm_phase<pg8::EpiGateT<false>, pg8::DenseOrder>(F.lds, 2 * AO, So, E, F.wave); }
        { pg8::DenseOrder So; So.init(B_SGI, B_WB, S, D, 2 * SW, F.G, F.bx); pg8::EpiGateT<true> E{B_MRG, B_GT, 2048, 1, B_MRG8};
          pg8::gemm_phase<pg8::EpiGateT<true>, pg8::DenseOrder>(F.lds, 2 * SW, So, E, F.wave); }
    }
    SEAM(4);
    if (IN(5)) { RELANE(); pg8::DenseOrder So; So.init(B_MRG8, B_WO8, S, D, D, F.G, F.bx); pg8::EpiX1 E{B_XB, B_X1F, 1.0f / (pg8::SC_MRG * pg8::SC_WO)};
        pg8::gemm_phase<pg8::EpiX1, pg8::DenseOrder, true>(F.lds, D, So, E, F.wave); }
    SEAM(5);
    if (IN(6)) { RELANE(); p6_ln_router(args, F); }
    SEAM(6);
    if (IN(7)) { RELANE(); compute_tp(F); if (F.bx == 0) { if (F.tid < 33) B_TPG[F.tid] = tp[F.tid]; if (F.tid >= 64 && F.tid < 96) B_TPG[33 + F.tid - 64] = ((const LAS int*)(F.lds + LDS_MISC + MISC_CNT))[F.tid - 64]; } p7_scatter(F); }
    SEAM(7);
    if (IN(8)) { RELANE(); load_tp(F); pg8::MoeOrder So; So.init(B_X1Q, B_WGU8, tp, __builtin_amdgcn_readfirstlane(tp[32]), 2 * DE, D, F.G, F.bx); pg8::EpiSwiglu8 E{B_HB8, ((const float*)args.in[15])};
        So.rowtok = B_ROWTOK; So.ids = (LAS unsigned*)(F.lds + LDS_MISC + MISC_PART);
        pg8::gemm_phase<pg8::EpiSwiglu8, pg8::MoeOrder, true, true, true>(F.lds, D, So, E, F.wave); }
    SEAM(8);
    if (IN(9)) { RELANE(); load_tp(F);
        const int ntl = __builtin_amdgcn_readfirstlane(tp[32]), nun = ntl * (D / pg8::BM), lfull = (nun / F.G) * F.G, rem = nun - lfull;
        const bool split = rem > 0 && 2 * rem <= F.G;
        pg8::EpiDown E{B_YB, ((const float*)args.in[17]), B_RGATE, 1.0f / (pg8::SC_H * pg8::SC_WD), (LAS float*)(F.lds + LDS_MISC + MISC_PART)};
        { pg8::MoeOrder So; So.init(B_HB8, B_WD8, tp, ntl, D, DE, F.G, F.bx); So.lim = split ? lfull : nun;
          pg8::gemm_phase<pg8::EpiDown, pg8::MoeOrder, true>(F.lds, DE, So, E, F.wave); }
        if (split) { pg8::MoeHalfOrder Sh; Sh.init(B_HB8, B_WD8, tp, ntl, D, DE, F.bx, lfull, rem);
          pg8::gemm_phase<pg8::EpiDown, pg8::MoeHalfOrder, true, true, false, true>(F.lds, DE, Sh, E, F.wave); }
    }
    SEAM(9);
    if (IN(10)) { RELANE(); p10_final(args, F); }
#undef IN
#undef SEAM
#undef RELANE
}

extern "C" void kernel_launch(void* const* d_in, const int* in_sizes, int n_in, void* d_out, int out_size, void* d_ws, size_t ws_size, hipStream_t stream) {
    static int grid = 0;
    if (grid == 0) {
        if (n_in != 20 || in_sizes[0] != S * D || out_size != S * D || ws_size < WS_END) {
            fprintf(stderr, "kernel_launch: unexpected shapes/workspace (n_in %d, in0 %d, out %d, ws %zu, need %zu); nothing launched\n", n_in, n_in > 0 ? in_sizes[0] : -1, out_size, ws_size, (size_t)WS_END); grid = -1; return; }
        int dev = 0, cus = 0, per_cu = 0;
        if (hipGetDevice(&dev) != hipSuccess || hipDeviceGetAttribute(&cus, hipDeviceAttributeMultiprocessorCount, dev) != hipSuccess) { grid = -1; return; }
        if (hipFuncSetAttribute((const void*)mk_fwd, hipFuncAttributeMaxDynamicSharedMemorySize, LDS_BYTES) != hipSuccess) { fprintf(stderr, "kernel_launch: hipFuncSetAttribute failed\n"); grid = -1; return; }
        if (hipOccupancyMaxActiveBlocksPerMultiprocessor(&per_cu, (const void*)mk_fwd, 512, LDS_BYTES) != hipSuccess || per_cu < 1)
            fprintf(stderr, "kernel_launch: note: occupancy query reports %d workgroups per CU\n", per_cu);
        (void)hipGetLastError();
        grid = cus;
    }
    if (grid < 0) return;
    if (hipMemsetAsync((char*)d_ws + WS_CTL, 0, CTL_ZERO_BYTES, stream) != hipSuccess) { fprintf(stderr, "kernel_launch: memset failed\n"); return; }
    Args a{};
    for (int i = 0; i < 20; ++i) a.in[i] = d_in[i];
    a.out = (float*)d_out; a.ws = (unsigned char*)d_ws;
    a.ph_lo = 0; a.ph_hi = N_PHASES;
    hipLaunchKernelGGL(mk_fwd, dim3(grid), dim3(512), LDS_BYTES, stream, a);
}
```
